# Optimizing an MI355X kernel written in HIP

```python
import math
import jax, jax.numpy as jnp
from jax import lax
import numpy as np

D_MODEL = 2048
BATCH = 1
SEQ = 16384
DEPTH = 1

N_HEADS = D_MODEL // 128
N_KV_HEADS = 4
HEAD_DIM = 64
GROUP = N_HEADS // N_KV_HEADS
WINDOW = 128
BLOCK = 128
ROPE_THETA = 10000.0
CONV_CH = D_MODEL // 4
CONV_WIDTH = 31
MEM_TOKENS = 256
MEM_HEADS = 4
MEM_HEAD_DIM = D_MODEL // (4 * MEM_HEADS)
ATTN_Q_W = N_HEADS * HEAD_DIM
KV_W = N_KV_HEADS * HEAD_DIM
MEM_W = MEM_HEADS * MEM_HEAD_DIM
N_BRANCH = 3
IN_W = ATTN_Q_W + 2 * KV_W + 2 * CONV_CH + MEM_W + N_BRANCH * D_MODEL
PEER_HEADS = 8
N_KEYS = 128
N_EXPERTS = N_KEYS * N_KEYS
PEER_TOPK = 16
PEER_QDIM = 256
PEER_HALF = PEER_QDIM // 2
PEER_CHUNK = 128
EPS = 1e-6
NEG = -1e30

kernel_name = "hybrid_swa_conformer_mem_peer_block"


def rms_norm(x, g):
    xf = x.astype(jnp.float32)
    y = xf * lax.rsqrt(jnp.mean(xf * xf, axis=-1, keepdims=True) + EPS)
    return (y * g.astype(jnp.float32)).astype(x.dtype)


def layer_norm(x, g, b):
    xf = x.astype(jnp.float32)
    mu = jnp.mean(xf, axis=-1, keepdims=True)
    xc = xf - mu
    y = xc * lax.rsqrt(jnp.mean(xc * xc, axis=-1, keepdims=True) + EPS)
    return (y * g.astype(jnp.float32) + b.astype(jnp.float32)).astype(x.dtype)


def rotary(x, cos, sin):
    xf = x.astype(jnp.float32)
    x1, x2 = jnp.split(xf, 2, axis=-1)
    return jnp.concatenate([x1 * cos - x2 * sin, x2 * cos + x1 * sin], axis=-1).astype(x.dtype)


def sliding_window_attention(q, k, v, sinks):
    B, S = q.shape[0], q.shape[1]
    nb = S // BLOCK
    q = q.reshape(B, nb, BLOCK, N_KV_HEADS, GROUP, HEAD_DIM)
    k = k.reshape(B, nb, BLOCK, N_KV_HEADS, HEAD_DIM)
    v = v.reshape(B, nb, BLOCK, N_KV_HEADS, HEAD_DIM)

    def with_prev(t):
        prev = jnp.concatenate([jnp.zeros_like(t[:, :1]), t[:, :-1]], axis=1)
        return jnp.concatenate([prev, t], axis=2)

    kb, vb = with_prev(k), with_prev(v)
    s = jnp.einsum('bnqhgd,bnkhd->bnhgqk', q, kb).astype(jnp.float32) * (HEAD_DIM ** -0.5)
    qi = jnp.arange(BLOCK)[:, None]
    kj = jnp.arange(2 * BLOCK)[None, :]
    diff = qi + BLOCK - kj
    band = (diff >= 0) & (diff < WINDOW)
    blk = jnp.arange(nb)[:, None, None]
    mask = band[None] & ((blk > 0) | (kj >= BLOCK)[None])
    s = jnp.where(mask[None, :, None, None], s, NEG)
    sink = jnp.broadcast_to(sinks.astype(jnp.float32).reshape(N_KV_HEADS, GROUP)[None, None, :, :, None, None],
                            s.shape[:-1] + (1,))
    p = jax.nn.softmax(jnp.concatenate([s, sink], axis=-1), axis=-1)[..., :-1].astype(v.dtype)
    o = jnp.einsum('bnhgqk,bnkhd->bnqhgd', p, vb)
    return o.reshape(B, S, N_HEADS * HEAD_DIM)


def conformer_conv(u, dw_w, dw_b, ln_g, ln_b, w_o):
    a, b = jnp.split(u, 2, axis=-1)
    glu = a * jax.nn.sigmoid(b)
    c = lax.conv_general_dilated(glu, dw_w, window_strides=(1,), padding=((CONV_WIDTH - 1, 0),),
                                 dimension_numbers=('NWC', 'WIO', 'NWC'),
                                 feature_group_count=CONV_CH) + dw_b
    c = layer_norm(c, ln_g, ln_b)
    return jax.nn.silu(c) @ w_o


def memory_attention(mq, mem, g_mem, w_mem_kv, mq_g, mk_g, w_o):
    B, S = mq.shape[0], mq.shape[1]
    mq = rms_norm(mq.reshape(B, S, MEM_HEADS, MEM_HEAD_DIM), mq_g)
    kv = rms_norm(mem, g_mem) @ w_mem_kv
    mk, mv = jnp.split(kv, 2, axis=-1)
    mk = rms_norm(mk.reshape(B, -1, MEM_HEADS, MEM_HEAD_DIM), mk_g)
    mv = mv.reshape(B, -1, MEM_HEADS, MEM_HEAD_DIM)
    s = jnp.einsum('bshd,bmhd->bhsm', mq, mk).astype(jnp.float32) * (MEM_HEAD_DIM ** -0.5)
    p = jax.nn.softmax(s, axis=-1).astype(mv.dtype)
    o = jnp.einsum('bhsm,bmhd->bshd', p, mv).reshape(B, S, MEM_W)
    return o @ w_o


def peer(h, w_query, sub_keys, expert_u, expert_v):
    B, S, D = h.shape
    q = (h @ w_query).reshape(B, S, PEER_HEADS, 2, PEER_HALF)
    sc = jnp.einsum('bshpd,hpnd->bshpn', q, sub_keys).astype(jnp.float32)
    vals, idx = lax.top_k(sc, PEER_TOPK)
    cand_s = (vals[..., 0, :, None] + vals[..., 1, None, :]).reshape(B, S, PEER_HEADS, PEER_TOPK * PEER_TOPK)
    cand_i = (idx[..., 0, :, None] * N_KEYS + idx[..., 1, None, :]).reshape(B, S, PEER_HEADS, PEER_TOPK * PEER_TOPK)
    top_s, pos = lax.top_k(cand_s, PEER_TOPK)
    experts = jnp.take_along_axis(cand_i, pos, axis=-1)
    gates = jax.nn.softmax(top_s, axis=-1).astype(h.dtype)
    n_chunks = (B * S) // PEER_CHUNK
    hf = h.reshape(n_chunks, PEER_CHUNK, D)
    ef = experts.reshape(n_chunks, PEER_CHUNK, PEER_HEADS * PEER_TOPK)
    gf = gates.reshape(n_chunks, PEER_CHUNK, PEER_HEADS * PEER_TOPK)

    def block(args):
        hc, ec, gc = args
        a = jnp.einsum('cd,ckd->ck', hc, expert_u[ec])
        act = jax.nn.gelu(a, approximate=False) * gc
        return jnp.einsum('ck,ckd->cd', act, expert_v[ec])

    return lax.map(block, (hf, ef, gf)).reshape(B, S, D)


def setup_inputs(seed: int = 0) -> dict:
    key = jax.random.key(seed)
    ks = jax.random.split(key, 32)
    L = DEPTH

    def nrm(k, shape, scale):
        return jax.random.normal(k, shape, jnp.float32) * scale

    return {
        "x": nrm(ks[0], (BATCH, SEQ, D_MODEL), 1.0),
        "mem": nrm(ks[1], (BATCH, MEM_TOKENS, D_MODEL), 1.0),
        "positions": jnp.tile(jnp.arange(SEQ, dtype=jnp.int32)[None], (BATCH, 1)),
        "g_mix": 1.0 + nrm(ks[2], (L, D_MODEL), 0.02),
        "w_in": nrm(ks[3], (L, D_MODEL, IN_W), D_MODEL ** -0.5),
        "q_norm_g": 1.0 + nrm(ks[4], (L, HEAD_DIM), 0.02),
        "k_norm_g": 1.0 + nrm(ks[5], (L, HEAD_DIM), 0.02),
        "attn_sinks": nrm(ks[6], (L, N_HEADS), 0.5),
        "w_attn_o": nrm(ks[7], (L, ATTN_Q_W, D_MODEL), ATTN_Q_W ** -0.5),
        "conv_dw_w": nrm(ks[8], (L, CONV_WIDTH, 1, CONV_CH), CONV_WIDTH ** -0.5),
        "conv_dw_b": nrm(ks[9], (L, CONV_CH), 0.02),
        "conv_ln_g": 1.0 + nrm(ks[10], (L, CONV_CH), 0.02),
        "conv_ln_b": nrm(ks[11], (L, CONV_CH), 0.02),
        "w_conv_o": nrm(ks[12], (L, CONV_CH, D_MODEL), CONV_CH ** -0.5),
        "g_mem": 1.0 + nrm(ks[13], (L, D_MODEL), 0.02),
        "w_mem_kv": nrm(ks[14], (L, D_MODEL, 2 * MEM_W), D_MODEL ** -0.5),
        "mq_norm_g": 1.0 + nrm(ks[15], (L, MEM_HEAD_DIM), 0.02),
        "mk_norm_g": 1.0 + nrm(ks[16], (L, MEM_HEAD_DIM), 0.02),
        "w_mem_o": nrm(ks[17], (L, MEM_W, D_MODEL), MEM_W ** -0.5),
        "w_out": nrm(ks[18], (L, D_MODEL, D_MODEL), D_MODEL ** -0.5),
        "g_ffn": 1.0 + nrm(ks[19], (L, D_MODEL), 0.02),
        "w_query": nrm(ks[20], (L, D_MODEL, PEER_HEADS * PEER_QDIM), D_MODEL ** -0.5),
        "sub_keys": nrm(ks[21], (L, PEER_HEADS, 2, N_KEYS, PEER_HALF), PEER_HALF ** -0.5),
        "expert_u": nrm(ks[22], (L, N_EXPERTS, D_MODEL), D_MODEL ** -0.5),
        "expert_v": nrm(ks[23], (L, N_EXPERTS, D_MODEL), (PEER_HEADS * PEER_TOPK) ** -0.5),
    }


def reference(x, mem, positions, g_mix, w_in, q_norm_g, k_norm_g, attn_sinks, w_attn_o,
              conv_dw_w, conv_dw_b, conv_ln_g, conv_ln_b, w_conv_o, g_mem, w_mem_kv,
              mq_norm_g, mk_norm_g, w_mem_o, w_out, g_ffn, w_query, sub_keys, expert_u, expert_v):
    B, S, _ = x.shape
    inv_freq = ROPE_THETA ** (-jnp.arange(0, HEAD_DIM, 2, dtype=jnp.float32) / HEAD_DIM)
    ang = positions.astype(jnp.float32)[..., None] * inv_freq
    cos, sin = jnp.cos(ang)[:, :, None, :], jnp.sin(ang)[:, :, None, :]
    splits = np.cumsum([ATTN_Q_W, KV_W, KV_W, 2 * CONV_CH, MEM_W, D_MODEL, D_MODEL]).tolist()

    for l in range(DEPTH):
        h = rms_norm(x, g_mix[l])
        proj = h @ w_in[l]
        q, k, v, conv_in, mq, ga, gc, gm = jnp.split(proj, splits, axis=-1)
        q = rotary(rms_norm(q.reshape(B, S, N_HEADS, HEAD_DIM), q_norm_g[l]), cos, sin)
        k = rotary(rms_norm(k.reshape(B, S, N_KV_HEADS, HEAD_DIM), k_norm_g[l]), cos, sin)
        v = v.reshape(B, S, N_KV_HEADS, HEAD_DIM)
        attn = sliding_window_attention(q, k, v, attn_sinks[l]) @ w_attn_o[l]
        conv = conformer_conv(conv_in, conv_dw_w[l], conv_dw_b[l], conv_ln_g[l], conv_ln_b[l], w_conv_o[l])
        memo = memory_attention(mq, mem, g_mem[l], w_mem_kv[l], mq_norm_g[l], mk_norm_g[l], w_mem_o[l])
        merged = jax.nn.sigmoid(ga) * attn + jax.nn.sigmoid(gc) * conv + jax.nn.sigmoid(gm) * memo
        x = x + merged @ w_out[l]
        x = x + peer(rms_norm(x, g_ffn[l]), w_query[l], sub_keys[l], expert_u[l], expert_v[l])
    return x
```

```cpp
#include <hip/hip_runtime.h>
#include <hip/hip_cooperative_groups.h>
#include <cstdio>
namespace cg = cooperative_groups;
namespace pg8 {
#define PG8_LAS __attribute__((address_space(3)))
typedef unsigned short bf16_t;
typedef short bf16x8 __attribute__((ext_vector_type(8)));
typedef float f32x4 __attribute__((ext_vector_type(4)));
typedef unsigned u32x4 __attribute__((ext_vector_type(4)));
constexpr int BM = 256, BK = 64, HALF = 128, HTB = HALF * BK * 2  , STAGE_BYTES = 8 * HTB, NXCD = 8, WGM = 8;

__host__ __device__ __forceinline__ int lds_byte(int r, int c) { const int st = (r >> 4) * 2 + (c >> 5), rr = r & 15, cc = c & 31, ob = rr * 64 + cc * 2; return st * 1024 + (ob ^ (((ob >> 9) & 1) << 5)); }
__host__ __device__ __forceinline__ void stage_rc(int b, int& R, int& C) { const int st = b / 1024, sb = b % 1024, swz = sb ^ (((sb >> 9) & 1) << 5); R = (st >> 1) * 16 + swz / 64; C = (st & 1) * 32 + (swz % 64) / 2; }
__host__ __device__ __forceinline__ int perm32(int rho) { const int n = rho >> 4, i = rho & 15; return 8 * (i >> 2) + 4 * n + (i & 3); }

struct Unit { int pm, pn; };
struct Gemm { const bf16_t* A; const bf16_t* Bt; int M, N, K; };

struct StaticOrder {
    int nM, nN, nwg, G, c;
    __host__ __device__ void init(int M, int N, int G_, int c_) { nM = M / BM; nN = N / BM; nwg = nM * nN; G = G_; c = c_; }
    __host__ __device__ bool next(int i, Unit& u) const {
        const long L = (long)i * G + c; if (L >= nwg) return false;
        int wgid = (int)L; { const int q = nwg / NXCD, r = nwg % NXCD, xcd = wgid % NXCD, off = wgid / NXCD; wgid = (xcd < r ? xcd * (q + 1) : r * (q + 1) + (xcd - r) * q) + off; }
        const int nig = WGM * nN, gid = wgid / nig, fm = gid * WGM, gsz = (nM - fm) < WGM ? (nM - fm) : WGM;
        u.pm = fm + ((wgid % nig) % gsz); u.pn = (wgid % nig) / gsz; return true;
    }
    __device__ __forceinline__ void a_ready(const Unit&) const {}
    __device__ __forceinline__ void done(const Unit&) const {}
};
__device__ __forceinline__ unsigned cvt_pk_bf16(float lo, float hi) { unsigned r; asm volatile("v_cvt_pk_bf16_f32 %0, %1, %2" : "=v"(r) : "v"(lo), "v"(hi)); return r; }
typedef float f32x2 __attribute__((ext_vector_type(2)));
template <class Epi, class Sched, bool STAMP = false>
__device__ __forceinline__ void gemm_phase(PG8_LAS unsigned char* lds, const Gemm g, const Sched& S, const Epi& E, unsigned long long* stamps) {
    const int tid = threadIdx.x, wid = __builtin_amdgcn_readfirstlane(tid >> 6), lane = tid & 63, wr = wid >> 2, wc = wid & 3, fr = lane & 15, fq = lane >> 4;
    const int K = g.K, nt = K / BK;
    int ts_lo = 0, ts_hi = 0, nts = 0; const unsigned long long rt_entry = STAMP ? (unsigned long long)wall_clock64() : 0ull;
#define PG8_STAMP() do { if (STAMP && wid == 0 && nts < 64) { const unsigned long long _c = (unsigned long long)clock64(); \
        ts_lo = (lane == nts) ? (int)(unsigned)_c : ts_lo; ts_hi = (lane == nts) ? (int)(unsigned)(_c >> 32) : ts_hi; ++nts; } } while (0)
    PG8_STAMP();
    unsigned voffA[2], voffB[2];
#pragma unroll
    for (int i = 0; i < 2; ++i) { int R, C; stage_rc(tid * 16 + i * 8192, R, C); const int Rb = ((R & ~31) + perm32(R & 31));
        voffA[i] = (unsigned)(R * K + C) * 2u; voffB[i] = (unsigned)(Rb * K + C) * 2u; }
    const size_t kstep = (size_t)(BK * 2);
    const size_t hstep = (size_t)HALF * K * 2;
    const size_t tstep = 2 * hstep;
    const unsigned ldsw = (unsigned)wid * 1024u;
    const int aoff = lds_byte(wr * 64 + fr, fq * 8), boff = lds_byte(wc * 32 + fr, fq * 8);
#define PG8_SA(b, h) (((b) * 2 + (h)) * HTB)
#define PG8_SB(b, h) ((4 + (b) * 2 + (h)) * HTB)
#define PG8_STAGE(bufoff, gbase, voff) do { _Pragma("unroll") for (int _i = 0; _i < 2; ++_i) \
        __builtin_amdgcn_global_load_lds((const unsigned*)((const char*)(gbase) + (voff)[_i]), (PG8_LAS unsigned*)(lds + (bufoff) + ldsw + _i * 8192), 16, 0, 0); } while (0)
#define PG8_LDA(dst, b, h) do { _Pragma("unroll") for (int m = 0; m < 4; ++m) _Pragma("unroll") for (int k = 0; k < 2; ++k) dst[m][k] = *(const PG8_LAS bf16x8*)(lds + PG8_SA(b, h) + aoff + m * 2048 + k * 1024); } while (0)
#define PG8_LDB(dst, b, h) do { _Pragma("unroll") for (int n = 0; n < 2; ++n) _Pragma("unroll") for (int k = 0; k < 2; ++k) dst[n][k] = *(const PG8_LAS bf16x8*)(lds + PG8_SB(b, h) + boff + n * 2048 + k * 1024); } while (0)
#define PG8_MMA(ai, bj, At, Bt) do { __builtin_amdgcn_s_setprio(1); _Pragma("unroll") for (int m = 0; m < 4; ++m) _Pragma("unroll") for (int n = 0; n < 2; ++n) _Pragma("unroll") for (int k = 0; k < 2; ++k) \
        acc[ai][bj][m][n] = __builtin_amdgcn_mfma_f32_16x16x32_bf16(Bt[n][k], At[m][k], acc[ai][bj][m][n], 0, 0, 0); __builtin_amdgcn_s_setprio(0); } while (0)
#define PG8_WAIT_V(n) asm volatile("s_waitcnt vmcnt(" #n ")" ::: "memory")
#define PG8_WAIT_L(n) asm volatile("s_waitcnt lgkmcnt(" #n ")" ::: "memory")
#define PG8_BAR __builtin_amdgcn_s_barrier()
#define PG8_SCHED __builtin_amdgcn_sched_barrier(0)
    Unit cur, nxt; int ui = 0;
    if (!S.next(0, cur)) return;
    f32x4 acc[2][2][4][2];
#pragma unroll
    for (int a = 0; a < 2; ++a)
#pragma unroll
        for (int b = 0; b < 2; ++b)
#pragma unroll
            for (int m = 0; m < 4; ++m)
#pragma unroll
                for (int n = 0; n < 2; ++n) acc[a][b][m][n] = (f32x4){0.f, 0.f, 0.f, 0.f};
    bf16x8 At[4][2], B0[2][2], B1[2][2];
    const char* cA = (const char*)g.A + (size_t)cur.pm * tstep; const char* cB = (const char*)g.Bt + (size_t)cur.pn * tstep;
    S.a_ready(cur);
    PG8_STAGE(PG8_SB(0, 0), cB, voffB); PG8_STAGE(PG8_SA(0, 0), cA, voffA); PG8_STAGE(PG8_SB(0, 1), cB + hstep, voffB); PG8_STAGE(PG8_SA(0, 1), cA + hstep, voffA);
    if (wr == 1) PG8_BAR;
    PG8_WAIT_V(4); PG8_BAR;
    PG8_STAGE(PG8_SB(1, 0), cB + kstep, voffB); PG8_STAGE(PG8_SA(1, 0), cA + kstep, voffA); PG8_STAGE(PG8_SB(1, 1), cB + hstep + kstep, voffB);
    PG8_WAIT_V(6); PG8_BAR;
    PG8_STAMP();
    for (;;) {
        const bool has_next = S.next(ui + 1, nxt);
        const char* nA = has_next ? (const char*)g.A + (size_t)nxt.pm * tstep : cA; const char* nB = has_next ? (const char*)g.Bt + (size_t)nxt.pn * tstep : cB;
        for (int t = 0; t < nt; t += 2) {
            const bool last = (t == nt - 2);
            const char* a1 = cA + (size_t)(t + 1) * kstep;
            const char* a2 = last ? nA : cA + (size_t)(t + 2) * kstep; const char* b2 = last ? nB : cB + (size_t)(t + 2) * kstep;
            const char* a3 = a2 + kstep; const char* b3 = b2 + kstep;
            if (last && has_next) S.a_ready(nxt);
            PG8_LDB(B0, 0, 0); PG8_SCHED; PG8_LDA(At, 0, 0); PG8_STAGE(PG8_SA(1, 1), a1 + hstep, voffA);
            PG8_WAIT_L(8); PG8_BAR; PG8_WAIT_L(0); PG8_MMA(0, 0, At, B0); PG8_BAR; PG8_SCHED;
            PG8_LDB(B1, 0, 1); PG8_STAGE(PG8_SB(0, 0), b2, voffB);
            PG8_BAR; PG8_WAIT_L(0); PG8_MMA(0, 1, At, B1); PG8_BAR;
            PG8_LDA(At, 0, 1); PG8_STAGE(PG8_SA(0, 0), a2, voffA);
            PG8_BAR; PG8_WAIT_L(0); PG8_MMA(1, 0, At, B0); PG8_BAR; PG8_SCHED;
            PG8_STAGE(PG8_SB(0, 1), b2 + hstep, voffB);
            PG8_WAIT_V(6); PG8_BAR; PG8_MMA(1, 1, At, B1); PG8_BAR;
            PG8_LDB(B0, 1, 0); PG8_SCHED; PG8_LDA(At, 1, 0); PG8_STAGE(PG8_SA(0, 1), a2 + hstep, voffA);
            PG8_WAIT_L(8); PG8_BAR; PG8_WAIT_L(0); PG8_MMA(0, 0, At, B0); PG8_BAR; PG8_SCHED;
            PG8_LDB(B1, 1, 1); PG8_STAGE(PG8_SB(1, 0), b3, voffB);
            PG8_BAR; PG8_WAIT_L(0); PG8_MMA(0, 1, At, B1); PG8_BAR;
            PG8_LDA(At, 1, 1); PG8_STAGE(PG8_SA(1, 0), a3, voffA);
            PG8_BAR; PG8_WAIT_L(0); PG8_MMA(1, 0, At, B0); PG8_BAR; PG8_SCHED;
            PG8_STAGE(PG8_SB(1, 1), b3 + hstep, voffB);
            PG8_WAIT_V(6); PG8_BAR; PG8_MMA(1, 1, At, B1); PG8_BAR;
        }
        PG8_STAMP();
        if constexpr (!Epi::AFTER_DRAIN) { E(acc, cur, wr, wc, fr, fq); S.done(cur); }
        PG8_STAMP();
        if (!has_next) break;
#pragma unroll
        for (int a = 0; a < 2; ++a)
#pragma unroll
            for (int b = 0; b < 2; ++b)
#pragma unroll
                for (int m = 0; m < 4; ++m)
#pragma unroll
                    for (int n = 0; n < 2; ++n) acc[a][b][m][n] = (f32x4){0.f, 0.f, 0.f, 0.f};
        cur = nxt; cA = nA; cB = nB; ++ui;
    }
    PG8_WAIT_V(0);
    if (wr == 0) PG8_BAR;
    PG8_BAR;
    if constexpr (Epi::AFTER_DRAIN) { E.fused(acc, cur, wr, wc, fr, fq, lds, wid, lane); S.done(cur); }
    PG8_STAMP();
    if (STAMP && wid == 0) { stamps[lane] = lane < nts ? (((unsigned long long)(unsigned)ts_hi << 32) | (unsigned)ts_lo) : 0ull;
        if (lane == 62) stamps[62] = rt_entry; if (lane == 63) stamps[63] = (unsigned long long)wall_clock64(); }
#undef PG8_STAMP
#undef PG8_SA
#undef PG8_SB
#undef PG8_STAGE
#undef PG8_LDA
#undef PG8_LDB
#undef PG8_MMA
#undef PG8_WAIT_V
#undef PG8_WAIT_L
#undef PG8_BAR
#undef PG8_SCHED
}
}

typedef unsigned short u16;
typedef unsigned int u32;
typedef short bf16x8 __attribute__((ext_vector_type(8)));
typedef float f32x4 __attribute__((ext_vector_type(4)));
typedef u32 u32x4 __attribute__((ext_vector_type(4)));
typedef u32 u32x2 __attribute__((ext_vector_type(2)));
typedef __bf16 bf16x2_t __attribute__((ext_vector_type(2)));

constexpr int S_ = 16384, D_ = 2048, INW = 9216;
constexpr int C_Q = 0, C_K = 1024, C_V = 1280, C_CA = 1536, C_CB = 2048, C_MQ = 2560, C_GA = 3072, C_GC = 5120, C_GM = 7168;
constexpr float EPS_ = 1e-6f, LOG2E = 1.4426950408889634f;
constexpr int LDS_BYTES = 147456, NTHR = 512;

constexpr size_t WS_WIN_T = 4096;
constexpr size_t WS_WA_T = WS_WIN_T + (size_t)INW * D_ * 2;
constexpr size_t WS_WC_T = WS_WA_T + (size_t)2048 * 1024 * 2;
constexpr size_t WS_WM_T = WS_WC_T + (size_t)2048 * 512 * 2;
constexpr size_t WS_WKV_T = WS_WM_T + (size_t)2048 * 512 * 2;
constexpr size_t WS_WOUT_T = WS_WKV_T + (size_t)1024 * 2048 * 2;
constexpr size_t WS_WQ_T = WS_WOUT_T + (size_t)2048 * 2048 * 2;
constexpr size_t WS_SK = WS_WQ_T + (size_t)2048 * 2048 * 2;
constexpr size_t WS_MEMN = WS_SK + (size_t)16 * 128 * 128 * 2;
constexpr size_t WS_MEMKV = WS_MEMN + (size_t)256 * 2048 * 2;
constexpr size_t WS_COS = WS_MEMKV + (size_t)256 * 1024 * 2;
constexpr size_t WS_SIN = WS_COS + (size_t)S_ * 32 * 4;
constexpr size_t WS_MERGED = WS_SIN + (size_t)S_ * 32 * 4;
constexpr size_t WS_PROJ = WS_MERGED + (size_t)S_ * D_ * 2;
constexpr size_t WS_EU = WS_PROJ;
constexpr size_t WS_EV = WS_EU + (size_t)16384 * 2048 * 2;
constexpr size_t WS_Q = WS_EV + (size_t)16384 * 2048 * 2;
constexpr size_t WS_SI = WS_Q + (size_t)S_ * 2048 * 2;
constexpr size_t WS_SG = WS_SI + (size_t)S_ * 128 * 4;
constexpr size_t WS_END = WS_PROJ + (size_t)S_ * INW * 2;
static_assert(WS_SG + (size_t)S_ * 128 * 4 <= WS_END, "peer scratch must fit the dead proj region");

struct Params {
    const float* x; const float* mem; const int* pos; const float* g_mix; const float* w_in; const float* qg; const float* kg; const float* sinks;
    const float* w_attn_o; const float* dw_w; const float* dw_b; const float* ln_g; const float* ln_b; const float* w_conv_o; const float* g_mem;
    const float* w_mem_kv; const float* mqg; const float* mkg; const float* w_mem_o; const float* w_out; const float* g_ffn; const float* w_query;
    const float* sub_keys; const float* eu; const float* ev;
    float* out; unsigned char* ws; int ph_lo, ph_hi;
};

__device__ __forceinline__ u32 pk_bf16(float lo, float hi) { u32 r; asm("v_cvt_pk_bf16_f32 %0, %1, %2" : "=v"(r) : "v"(lo), "v"(hi)); return r; }
__device__ __forceinline__ float bf_lo(u32 w) { return __uint_as_float(w << 16); }
__device__ __forceinline__ float bf_hi(u32 w) { return __uint_as_float(w & 0xffff0000u); }
__device__ __forceinline__ float fast_sigmoid(float x) { return __builtin_amdgcn_rcpf(1.f + __builtin_amdgcn_exp2f(-x * LOG2E)); }
template <int CTRL> __device__ __forceinline__ float dppf(float v) { return __builtin_bit_cast(float, __builtin_amdgcn_update_dpp(0, __builtin_bit_cast(int, v), CTRL, 0xf, 0xf, true)); }
__device__ __forceinline__ float row_sum16(float v) { v += dppf<0xB1>(v); v += dppf<0x4E>(v); v += dppf<0x141>(v); v += dppf<0x140>(v); return v; }
__device__ __forceinline__ float rdlane(float v, int l) { return __builtin_bit_cast(float, __builtin_amdgcn_readlane(__builtin_bit_cast(int, v), l)); }
__device__ __forceinline__ float wave_sum(float v) { v = row_sum16(v); return (rdlane(v, 0) + rdlane(v, 16)) + (rdlane(v, 32) + rdlane(v, 48)); }
__device__ __forceinline__ float dot2bf(u32 a, u32 b, float acc) { return __builtin_amdgcn_fdot2_f32_bf16(__builtin_bit_cast(bf16x2_t, a), __builtin_bit_cast(bf16x2_t, b), acc, false); }
__device__ __forceinline__ f32x4 mfma16(bf16x8 a, bf16x8 b, f32x4 c) { return __builtin_amdgcn_mfma_f32_16x16x32_bf16(a, b, c, 0, 0, 0); }
__device__ __forceinline__ u32 mono_key(float x) { u32 u = __float_as_uint(x); return (u & 0x80000000u) ? ~u : (u | 0x80000000u); }

struct EpiU {
    static constexpr bool PERM = true, AFTER_DRAIN = false;
    int mode;
    u16* O; float* Of; const float* X; const u16* G; int ldc; int ldg; int sig_from; int first;
    __device__ __forceinline__ void operator()(const pg8::f32x4 (&acc)[2][2][4][2], const pg8::Unit& u, int wr, int wc, int fr, int fq) const {
        const int row0 = u.pm * 256 + wr * 64 + fr, col0 = u.pn * 256 + wc * 32 + 8 * fq;
        if (mode == 0) {
            const bool sg = (u.pn * 256) >= sig_from;
#pragma unroll
            for (int ai = 0; ai < 2; ++ai)
#pragma unroll
                for (int m = 0; m < 4; ++m) { u16* rowp = O + (size_t)(row0 + ai * 128 + m * 16) * ldc + col0;
#pragma unroll
                    for (int bj = 0; bj < 2; ++bj) { f32x4 v0 = acc[ai][bj][m][0], v1 = acc[ai][bj][m][1];
                        if (sg) {
#pragma unroll
                            for (int j = 0; j < 4; ++j) { v0[j] = fast_sigmoid(v0[j]); v1[j] = fast_sigmoid(v1[j]); } }
                        u32x4 w; w.x = pk_bf16(v0[0], v0[1]); w.y = pk_bf16(v0[2], v0[3]); w.z = pk_bf16(v1[0], v1[1]); w.w = pk_bf16(v1[2], v1[3]);
                        *(u32x4*)(rowp + bj * 128) = w; } }
        } else if (mode == 1) {
#pragma unroll
            for (int ai = 0; ai < 2; ++ai)
#pragma unroll
                for (int m = 0; m < 4; ++m) { const size_t r = (size_t)(row0 + ai * 128 + m * 16);
#pragma unroll
                    for (int bj = 0; bj < 2; ++bj) { f32x4 v0 = acc[ai][bj][m][0], v1 = acc[ai][bj][m][1];
                        const u32x4 g = *(const u32x4*)(G + r * ldg + col0 + bj * 128);
                        u32x4 pv = (u32x4){0u, 0u, 0u, 0u}; u16* op = O + r * ldc + col0 + bj * 128;
                        if (!first) pv = *(const u32x4*)op;
                        u32x4 w;
                        w.x = pk_bf16(bf_lo(pv.x) + bf_lo(g.x) * v0[0], bf_hi(pv.x) + bf_hi(g.x) * v0[1]);
                        w.y = pk_bf16(bf_lo(pv.y) + bf_lo(g.y) * v0[2], bf_hi(pv.y) + bf_hi(g.y) * v0[3]);
                        w.z = pk_bf16(bf_lo(pv.z) + bf_lo(g.z) * v1[0], bf_hi(pv.z) + bf_hi(g.z) * v1[1]);
                        w.w = pk_bf16(bf_lo(pv.w) + bf_lo(g.w) * v1[2], bf_hi(pv.w) + bf_hi(g.w) * v1[3]);
                        *(u32x4*)op = w; } }
        } else {
#pragma unroll
            for (int ai = 0; ai < 2; ++ai)
#pragma unroll
                for (int m = 0; m < 4; ++m) { const size_t r = (size_t)(row0 + ai * 128 + m * 16);
#pragma unroll
                    for (int bj = 0; bj < 2; ++bj) {
                        const size_t o = r * ldc + col0 + bj * 128;
                        const f32x4 x0 = *(const f32x4*)(X + o), x1 = *(const f32x4*)(X + o + 4);
                        *(f32x4*)(Of + o) = x0 + acc[ai][bj][m][0]; *(f32x4*)(Of + o + 4) = x1 + acc[ai][bj][m][1]; } }
        }
    }
};

__device__ __forceinline__ void cvt_tr_tile(const float* __restrict__ src, u16* __restrict__ dst, int R, int C, int tile, float* T) {
    const int ntc = C >> 6, tr = tile / ntc, tc = tile - tr * ntc, tid = threadIdx.x;
#pragma unroll
    for (int i = 0; i < 2; ++i) { const int idx = tid + i * NTHR, r = idx >> 4, c4 = idx & 15;
        const f32x4 v = *(const f32x4*)(src + (size_t)(tr * 64 + r) * C + tc * 64 + c4 * 4);
        float* t = T + r * 65 + c4 * 4; t[0] = v[0]; t[1] = v[1]; t[2] = v[2]; t[3] = v[3]; }
    __syncthreads();
    { const int c = tid >> 3, r0 = (tid & 7) * 8; float v[8];
#pragma unroll
        for (int j = 0; j < 8; ++j) v[j] = T[(r0 + j) * 65 + c];
        u32x4 w; w.x = pk_bf16(v[0], v[1]); w.y = pk_bf16(v[2], v[3]); w.z = pk_bf16(v[4], v[5]); w.w = pk_bf16(v[6], v[7]);
        *(u32x4*)(dst + (size_t)(tc * 64 + c) * R + tr * 64 + r0) = w; }
    __syncthreads();
}
__device__ __forceinline__ void rms_row(const float* __restrict__ x, const float* __restrict__ g, u16* __restrict__ out, int lane) {
    f32x4 v[8]; float ss = 0.f;
#pragma unroll
    for (int i = 0; i < 8; ++i) { v[i] = ((const f32x4*)x)[i * 64 + lane]; ss += v[i][0] * v[i][0] + v[i][1] * v[i][1] + v[i][2] * v[i][2] + v[i][3] * v[i][3]; }
    ss = wave_sum(ss);
    const float rs = rsqrtf(ss * (1.f / 2048.f) + EPS_);
#pragma unroll
    for (int i = 0; i < 8; ++i) { const f32x4 gg = ((const f32x4*)g)[i * 64 + lane];
        u32x2 w; w.x = pk_bf16(v[i][0] * rs * gg[0], v[i][1] * rs * gg[1]); w.y = pk_bf16(v[i][2] * rs * gg[2], v[i][3] * rs * gg[3]);
        ((u32x2*)out)[i * 64 + lane] = w; }
}
__device__ __forceinline__ void sincos_d(double r, double& s, double& c) {
    const double r2 = r * r; double ts = 1.0, tc = 1.0;
    double ss = 0.0, cc = 0.0;
    double term_s = 1.0, term_c = 1.0; ss = 1.0; cc = 1.0;
#pragma unroll
    for (int k = 1; k <= 15; ++k) { term_c *= -r2 / (double)((2 * k - 1) * (2 * k)); term_s *= -r2 / (double)((2 * k) * (2 * k + 1)); cc += term_c; ss += term_s; }
    (void)ts; (void)tc;
    s = r * ss; c = cc;
}
__device__ __forceinline__ void phase_prep(const Params& p, unsigned char* lds) {
    float* T = (float*)lds;
    unsigned char* ws = p.ws;
    const int tid = threadIdx.x, lane = tid & 63, wave = tid >> 6;
    for (int it = blockIdx.x; it < 8192; it += gridDim.x) {
        if (it < 4608) cvt_tr_tile(p.w_in, (u16*)(ws + WS_WIN_T), 2048, INW, it, T);
        else if (it < 5120) cvt_tr_tile(p.w_attn_o, (u16*)(ws + WS_WA_T), 1024, 2048, it - 4608, T);
        else if (it < 5376) cvt_tr_tile(p.w_conv_o, (u16*)(ws + WS_WC_T), 512, 2048, it - 5120, T);
        else if (it < 5632) cvt_tr_tile(p.w_mem_o, (u16*)(ws + WS_WM_T), 512, 2048, it - 5376, T);
        else if (it < 6144) cvt_tr_tile(p.w_mem_kv, (u16*)(ws + WS_WKV_T), 2048, 1024, it - 5632, T);
        else if (it < 7168) cvt_tr_tile(p.w_out, (u16*)(ws + WS_WOUT_T), 2048, 2048, it - 6144, T);
        else cvt_tr_tile(p.w_query, (u16*)(ws + WS_WQ_T), 2048, 2048, it - 7168, T);
    }
    for (int r = blockIdx.x * 8 + wave; r < S_ + 256; r += gridDim.x * 8) {
        if (r < S_) rms_row(p.x + (size_t)r * D_, p.g_mix, (u16*)p.out + (size_t)r * D_, lane);
        else rms_row(p.mem + (size_t)(r - S_) * D_, p.g_mem, (u16*)(ws + WS_MEMN) + (size_t)(r - S_) * D_, lane);
    }
    const int gt = blockIdx.x * NTHR + tid, gn = gridDim.x * NTHR;
    for (int i = gt; i < S_ * 32; i += gn) { const int t = i >> 5, j = i & 31;
        const double invf = exp2(-(double)j * (13.287712379549449 / 32.0));
        const double ang = (double)p.pos[t] * invf;
        const double n = rint(ang * 0.15915494309189535);
        double r = fma(-n, 6.283185307179586, ang); r = fma(-n, 2.4492935982947064e-16, r);
        double s, c; sincos_d(r, s, c);
        ((float*)(ws + WS_COS))[i] = (float)c; ((float*)(ws + WS_SIN))[i] = (float)s; }
    for (int i = gt; i < 16 * 128 * 128 / 4; i += gn) { const f32x4 v = ((const f32x4*)p.sub_keys)[i]; u32x2 w; w.x = pk_bf16(v[0], v[1]); w.y = pk_bf16(v[2], v[3]); ((u32x2*)(ws + WS_SK))[i] = w; }
}

#ifndef MIX_MASK
#define MIX_MASK 7
#endif
__device__ __forceinline__ void swa_item(const Params& p, int item, unsigned char* lds, float mbound_nat) {
    const u16* __restrict__ proj = (const u16*)(p.ws + WS_PROJ);
    const float* __restrict__ COS = (const float*)(p.ws + WS_COS); const float* __restrict__ SIN = (const float*)(p.ws + WS_SIN);
    u16* Ks = (u16*)lds;
    u16* Vt = (u16*)(lds + 27648);
    const int qt = item >> 2, kh = item & 3, t0 = qt * 64;
    const int tid = threadIdx.x, lane = tid & 63, wave = tid >> 6, fr = lane & 15, fq = lane >> 4;
#pragma unroll
    for (int ps = 0; ps < 3; ++ps) { const int idx = ps * NTHR + tid, key = idx >> 3, l8 = idx & 7, t = t0 - 128 + key;
        float x[8];
#pragma unroll
        for (int j = 0; j < 8; ++j) x[j] = 0.f;
        f32x4 cs = (f32x4){1.f, 1.f, 1.f, 1.f}, sn = (f32x4){0.f, 0.f, 0.f, 0.f};
        if (t >= 0) { const u16* kp = proj + (size_t)t * INW + C_K + kh * 64 + l8 * 4;
            const u32x2 a = *(const u32x2*)kp, b = *(const u32x2*)(kp + 32);
            x[0] = bf_lo(a.x); x[1] = bf_hi(a.x); x[2] = bf_lo(a.y); x[3] = bf_hi(a.y); x[4] = bf_lo(b.x); x[5] = bf_hi(b.x); x[6] = bf_lo(b.y); x[7] = bf_hi(b.y);
            cs = *(const f32x4*)(COS + t * 32 + l8 * 4); sn = *(const f32x4*)(SIN + t * 32 + l8 * 4); }
        float ss = 0.f;
#pragma unroll
        for (int j = 0; j < 8; ++j) ss += x[j] * x[j];
        ss += __shfl_xor(ss, 1); ss += __shfl_xor(ss, 2); ss += __shfl_xor(ss, 4);
        const float rs = rsqrtf(ss * (1.f / 64.f) + EPS_);
        const f32x4 g1 = *(const f32x4*)(p.kg + l8 * 4), g2 = *(const f32x4*)(p.kg + 32 + l8 * 4);
        float o1[4], o2[4];
#pragma unroll
        for (int j = 0; j < 4; ++j) { const float y1 = x[j] * rs * g1[j], y2 = x[4 + j] * rs * g2[j]; o1[j] = y1 * cs[j] - y2 * sn[j]; o2[j] = y2 * cs[j] + y1 * sn[j]; }
        u32x2 w1, w2; w1.x = pk_bf16(o1[0], o1[1]); w1.y = pk_bf16(o1[2], o1[3]); w2.x = pk_bf16(o2[0], o2[1]); w2.y = pk_bf16(o2[2], o2[3]);
        *(u32x2*)(Ks + key * 72 + l8 * 4) = w1; *(u32x2*)(Ks + key * 72 + 32 + l8 * 4) = w2; }
#pragma unroll
    for (int ps = 0; ps < 3; ++ps) { const int idx = ps * NTHR + tid, key = idx >> 3, c8 = idx & 7, t = t0 - 128 + key;
        u32x4 w = (u32x4){0u, 0u, 0u, 0u};
        if (t >= 0) w = *(const u32x4*)(proj + (size_t)t * INW + C_V + kh * 64 + c8 * 8);
        u16* vp = Vt + (c8 * 8) * 200 + key;
        vp[0] = (u16)w.x; vp[200] = (u16)(w.x >> 16); vp[400] = (u16)w.y; vp[600] = (u16)(w.y >> 16);
        vp[800] = (u16)w.z; vp[1000] = (u16)(w.z >> 16); vp[1200] = (u16)w.w; vp[1400] = (u16)(w.w >> 16); }
    __syncthreads();
    {
        const int g = wave >> 1, half = wave & 1, head = kh * 4 + g, tw0 = t0 + half * 32;
        const float sinkv = p.sinks[head];
        const float mb = fmaxf(mbound_nat, sinkv) * LOG2E;
        const float qscale = 0.125f * LOG2E;
        bf16x8 qf[2][2];
#pragma unroll
        for (int mt = 0; mt < 2; ++mt) { const int t = tw0 + mt * 16 + fr;
            const u16* qp = proj + (size_t)t * INW + C_Q + head * 64 + fq * 8;
            const u32x4 a = *(const u32x4*)qp, b = *(const u32x4*)(qp + 32);
            float x1[8], x2[8];
            x1[0] = bf_lo(a.x); x1[1] = bf_hi(a.x); x1[2] = bf_lo(a.y); x1[3] = bf_hi(a.y); x1[4] = bf_lo(a.z); x1[5] = bf_hi(a.z); x1[6] = bf_lo(a.w); x1[7] = bf_hi(a.w);
            x2[0] = bf_lo(b.x); x2[1] = bf_hi(b.x); x2[2] = bf_lo(b.y); x2[3] = bf_hi(b.y); x2[4] = bf_lo(b.z); x2[5] = bf_hi(b.z); x2[6] = bf_lo(b.w); x2[7] = bf_hi(b.w);
            float ss = 0.f;
#pragma unroll
            for (int j = 0; j < 8; ++j) ss += x1[j] * x1[j] + x2[j] * x2[j];
            ss += __shfl_xor(ss, 16); ss += __shfl_xor(ss, 32);
            const float rs = rsqrtf(ss * (1.f / 64.f) + EPS_) * qscale;
            float o1[8], o2[8];
#pragma unroll
            for (int j = 0; j < 8; ++j) { const float c = COS[t * 32 + fq * 8 + j], s = SIN[t * 32 + fq * 8 + j];
                const float y1 = x1[j] * rs * p.qg[fq * 8 + j], y2 = x2[j] * rs * p.qg[32 + fq * 8 + j];
                o1[j] = y1 * c - y2 * s; o2[j] = y2 * c + y1 * s; }
            u32x4 w1, w2;
            w1.x = pk_bf16(o1[0], o1[1]); w1.y = pk_bf16(o1[2], o1[3]); w1.z = pk_bf16(o1[4], o1[5]); w1.w = pk_bf16(o1[6], o1[7]);
            w2.x = pk_bf16(o2[0], o2[1]); w2.y = pk_bf16(o2[2], o2[3]); w2.z = pk_bf16(o2[4], o2[5]); w2.w = pk_bf16(o2[6], o2[7]);
            qf[mt][0] = __builtin_bit_cast(bf16x8, w1); qf[mt][1] = __builtin_bit_cast(bf16x8, w2); }
        f32x4 sacc[10][2];
#pragma unroll
        for (int n = 0; n < 10; ++n) { sacc[n][0] = (f32x4){0.f, 0.f, 0.f, 0.f}; sacc[n][1] = (f32x4){0.f, 0.f, 0.f, 0.f}; }
#pragma unroll
        for (int n = 0; n < 10; ++n) { const int nt = 2 * half + n;
#pragma unroll
            for (int ks = 0; ks < 2; ++ks) { const bf16x8 kf = *(const bf16x8*)(Ks + (nt * 16 + fr) * 72 + ks * 32 + fq * 8);
                sacc[n][0] = mfma16(kf, qf[0][ks], sacc[n][0]); sacc[n][1] = mfma16(kf, qf[1][ks], sacc[n][1]); } }
        float lsum[2] = {0.f, 0.f};
        u32x2 pw[10][2];
#pragma unroll
        for (int n = 0; n < 10; ++n) { const int nt = 2 * half + n;
#pragma unroll
            for (int mt = 0; mt < 2; ++mt) { const int t = tw0 + mt * 16 + fr; float pv[4];
#pragma unroll
                for (int j = 0; j < 4; ++j) { const int s = t0 - 128 + nt * 16 + fq * 4 + j, df = t - s;
                    const bool ok = (df >= 0) && (df < 128) && (s >= 0);
                    pv[j] = ok ? __builtin_amdgcn_exp2f(sacc[n][mt][j] - mb) : 0.f; lsum[mt] += pv[j]; }
                pw[n][mt].x = pk_bf16(pv[0], pv[1]); pw[n][mt].y = pk_bf16(pv[2], pv[3]); } }
        f32x4 oacc[4][2];
#pragma unroll
        for (int d = 0; d < 4; ++d) { oacc[d][0] = (f32x4){0.f, 0.f, 0.f, 0.f}; oacc[d][1] = (f32x4){0.f, 0.f, 0.f, 0.f}; }
#pragma unroll
        for (int kk = 0; kk < 5; ++kk) { const int nta = 2 * half + 2 * kk;
            u32x4 b0, b1; b0.x = pw[2 * kk][0].x; b0.y = pw[2 * kk][0].y; b0.z = pw[2 * kk + 1][0].x; b0.w = pw[2 * kk + 1][0].y;
            b1.x = pw[2 * kk][1].x; b1.y = pw[2 * kk][1].y; b1.z = pw[2 * kk + 1][1].x; b1.w = pw[2 * kk + 1][1].y;
            const bf16x8 pf0 = __builtin_bit_cast(bf16x8, b0), pf1 = __builtin_bit_cast(bf16x8, b1);
#pragma unroll
            for (int d = 0; d < 4; ++d) { const u16* vp = Vt + (d * 16 + fr) * 200 + nta * 16 + fq * 4;
                const u32x2 va = *(const u32x2*)vp, vb = *(const u32x2*)(vp + 16);
                u32x4 vv; vv.x = va.x; vv.y = va.y; vv.z = vb.x; vv.w = vb.y; const bf16x8 vf = __builtin_bit_cast(bf16x8, vv);
                oacc[d][0] = mfma16(vf, pf0, oacc[d][0]); oacc[d][1] = mfma16(vf, pf1, oacc[d][1]); } }
        const float sk = __builtin_amdgcn_exp2f(sinkv * LOG2E - mb);
        u16* BOA = (u16*)((unsigned char*)p.out + 67108864);
#pragma unroll
        for (int mt = 0; mt < 2; ++mt) { float l = lsum[mt]; l += __shfl_xor(l, 16); l += __shfl_xor(l, 32); l += sk;
            const float inv = 1.f / l; const int t = tw0 + mt * 16 + fr;
#pragma unroll
            for (int d = 0; d < 4; ++d) { u32x2 w; w.x = pk_bf16(oacc[d][mt][0] * inv, oacc[d][mt][1] * inv); w.y = pk_bf16(oacc[d][mt][2] * inv, oacc[d][mt][3] * inv);
                *(u32x2*)(BOA + (size_t)t * 1024 + head * 64 + d * 16 + fq * 4) = w; } }
    }
    __syncthreads();
}

__device__ __forceinline__ void mem_item(const Params& p, int item, unsigned char* lds, float mbound_nat) {
    const u16* __restrict__ proj = (const u16*)(p.ws + WS_PROJ);
    const u16* __restrict__ MKV = (const u16*)(p.ws + WS_MEMKV);
    u16* Ks = (u16*)lds;
    u16* Vt = (u16*)(lds + 69632);
    const int tt = item >> 2, h = item & 3, t0 = tt * 128;
    const int tid = threadIdx.x, lane = tid & 63, wave = tid >> 6, fr = lane & 15, fq = lane >> 4;
#pragma unroll
    for (int ps = 0; ps < 8; ++ps) { const int idx = ps * NTHR + tid, key = idx >> 4, l16 = idx & 15;
        const u32x4 a = *(const u32x4*)(MKV + (size_t)key * 1024 + h * 128 + l16 * 8);
        float x[8]; x[0] = bf_lo(a.x); x[1] = bf_hi(a.x); x[2] = bf_lo(a.y); x[3] = bf_hi(a.y); x[4] = bf_lo(a.z); x[5] = bf_hi(a.z); x[6] = bf_lo(a.w); x[7] = bf_hi(a.w);
        float ss = 0.f;
#pragma unroll
        for (int j = 0; j < 8; ++j) ss += x[j] * x[j];
        ss += __shfl_xor(ss, 1); ss += __shfl_xor(ss, 2); ss += __shfl_xor(ss, 4); ss += __shfl_xor(ss, 8);
        const float rs = rsqrtf(ss * (1.f / 128.f) + EPS_);
        const f32x4 g1 = *(const f32x4*)(p.mkg + l16 * 8), g2 = *(const f32x4*)(p.mkg + l16 * 8 + 4);
        u32x4 w; w.x = pk_bf16(x[0] * rs * g1[0], x[1] * rs * g1[1]); w.y = pk_bf16(x[2] * rs * g1[2], x[3] * rs * g1[3]);
        w.z = pk_bf16(x[4] * rs * g2[0], x[5] * rs * g2[1]); w.w = pk_bf16(x[6] * rs * g2[2], x[7] * rs * g2[3]);
        *(u32x4*)(Ks + key * 136 + l16 * 8) = w;
        const u32x4 v = *(const u32x4*)(MKV + (size_t)key * 1024 + 512 + h * 128 + l16 * 8);
        u16* vp = Vt + (l16 * 8) * 264 + key;
        vp[0] = (u16)v.x; vp[264] = (u16)(v.x >> 16); vp[528] = (u16)v.y; vp[792] = (u16)(v.y >> 16);
        vp[1056] = (u16)v.z; vp[1320] = (u16)(v.z >> 16); vp[1584] = (u16)v.w; vp[1848] = (u16)(v.w >> 16); }
    __syncthreads();
    {
        const float mb = mbound_nat * LOG2E;
        const float qscale = 0.08838834764831845f * LOG2E;
        const int t = t0 + wave * 16 + fr;
        bf16x8 qf[4];
        { u32x4 a[4]; float ss = 0.f;
#pragma unroll
            for (int ks = 0; ks < 4; ++ks) { a[ks] = *(const u32x4*)(proj + (size_t)t * INW + C_MQ + h * 128 + ks * 32 + fq * 8);
                const float x0 = bf_lo(a[ks].x), x1 = bf_hi(a[ks].x), x2 = bf_lo(a[ks].y), x3 = bf_hi(a[ks].y), x4 = bf_lo(a[ks].z), x5 = bf_hi(a[ks].z), x6 = bf_lo(a[ks].w), x7 = bf_hi(a[ks].w);
                ss += x0 * x0 + x1 * x1 + x2 * x2 + x3 * x3 + x4 * x4 + x5 * x5 + x6 * x6 + x7 * x7; }
            ss += __shfl_xor(ss, 16); ss += __shfl_xor(ss, 32);
            const float rs = rsqrtf(ss * (1.f / 128.f) + EPS_) * qscale;
#pragma unroll
            for (int ks = 0; ks < 4; ++ks) { const float* gp = p.mqg + ks * 32 + fq * 8; u32x4 w;
                w.x = pk_bf16(bf_lo(a[ks].x) * rs * gp[0], bf_hi(a[ks].x) * rs * gp[1]); w.y = pk_bf16(bf_lo(a[ks].y) * rs * gp[2], bf_hi(a[ks].y) * rs * gp[3]);
                w.z = pk_bf16(bf_lo(a[ks].z) * rs * gp[4], bf_hi(a[ks].z) * rs * gp[5]); w.w = pk_bf16(bf_lo(a[ks].w) * rs * gp[6], bf_hi(a[ks].w) * rs * gp[7]);
                qf[ks] = __builtin_bit_cast(bf16x8, w); } }
        f32x4 sacc[16];
#pragma unroll
        for (int n = 0; n < 16; ++n) sacc[n] = (f32x4){0.f, 0.f, 0.f, 0.f};
#pragma unroll
        for (int n = 0; n < 16; ++n)
#pragma unroll
            for (int ks = 0; ks < 4; ++ks) { const bf16x8 kf = *(const bf16x8*)(Ks + (n * 16 + fr) * 136 + ks * 32 + fq * 8); sacc[n] = mfma16(kf, qf[ks], sacc[n]); }
        float lsum = 0.f; u32x2 pw[16];
#pragma unroll
        for (int n = 0; n < 16; ++n) { float pv[4];
#pragma unroll
            for (int j = 0; j < 4; ++j) { pv[j] = __builtin_amdgcn_exp2f(sacc[n][j] - mb); lsum += pv[j]; }
            pw[n].x = pk_bf16(pv[0], pv[1]); pw[n].y = pk_bf16(pv[2], pv[3]); }
        f32x4 oacc[8];
#pragma unroll
        for (int d = 0; d < 8; ++d) oacc[d] = (f32x4){0.f, 0.f, 0.f, 0.f};
#pragma unroll
        for (int kk = 0; kk < 8; ++kk) { u32x4 b; b.x = pw[2 * kk].x; b.y = pw[2 * kk].y; b.z = pw[2 * kk + 1].x; b.w = pw[2 * kk + 1].y;
            const bf16x8 pf = __builtin_bit_cast(bf16x8, b);
#pragma unroll
            for (int d = 0; d < 8; ++d) { const u16* vp = Vt + (d * 16 + fr) * 264 + kk * 32 + fq * 4;
                const u32x2 va = *(const u32x2*)vp, vb = *(const u32x2*)(vp + 16);
                u32x4 vv; vv.x = va.x; vv.y = va.y; vv.z = vb.x; vv.w = vb.y;
                oacc[d] = mfma16(__builtin_bit_cast(bf16x8, vv), pf, oacc[d]); } }
        lsum += __shfl_xor(lsum, 16); lsum += __shfl_xor(lsum, 32);
        const float inv = 1.f / lsum;
        u16* BOM = (u16*)((unsigned char*)p.out + 67108864 + 33554432 + 16777216);
#pragma unroll
        for (int d = 0; d < 8; ++d) { u32x2 w; w.x = pk_bf16(oacc[d][0] * inv, oacc[d][1] * inv); w.y = pk_bf16(oacc[d][2] * inv, oacc[d][3] * inv);
            *(u32x2*)(BOM + (size_t)t * 512 + h * 128 + d * 16 + fq * 4) = w; }
    }
    __syncthreads();
}

__device__ __forceinline__ void conv_item(const Params& p, int item, unsigned char* lds) {
    const u16* __restrict__ proj = (const u16*)(p.ws + WS_PROJ);
    float* G = (float*)lds;
    float* red = (float*)(lds + 126976);
    const int tid = threadIdx.x, cp = tid & 255, hi = tid >> 8, lane = tid & 63, wave = tid >> 6;
    const int t0 = item * 32;
    for (int i = 0; i < 31; ++i) { const int r = 2 * i + hi, t = t0 - 30 + r; float gx = 0.f, gy = 0.f;
        if (t >= 0) { const u32 a = *(const u32*)(proj + (size_t)t * INW + C_CA + 2 * cp), b = *(const u32*)(proj + (size_t)t * INW + C_CB + 2 * cp);
            gx = bf_lo(a) * fast_sigmoid(bf_lo(b)); gy = bf_hi(a) * fast_sigmoid(bf_hi(b)); }
        G[r * 512 + 2 * cp] = gx; G[r * 512 + 2 * cp + 1] = gy; }
    __syncthreads();
    const int ch = tid;
    const float bias = p.dw_b[ch];
    float cv[32];
#pragma unroll
    for (int sub = 0; sub < 4; ++sub) { const int base = sub * 8;
        float g[38];
#pragma unroll
        for (int r = 0; r < 38; ++r) g[r] = G[(base + r) * 512 + ch];
        float ac[8];
#pragma unroll
        for (int o = 0; o < 8; ++o) ac[o] = bias;
#pragma unroll
        for (int j = 0; j < 31; ++j) { const float w = p.dw_w[j * 512 + ch];
#pragma unroll
            for (int o = 0; o < 8; ++o) ac[o] += w * g[o + j]; }
#pragma unroll
        for (int o = 0; o < 8; ++o) cv[sub * 8 + o] = ac[o]; }
#pragma unroll
    for (int k = 0; k < 32; ++k) { const float s = wave_sum(cv[k]), q = wave_sum(cv[k] * cv[k]);
        if (lane == 0) { red[wave * 64 + k] = s; red[wave * 64 + 32 + k] = q; } }
    __syncthreads();
    if (tid < 64) { float t = 0.f;
#pragma unroll
        for (int w = 0; w < 8; ++w) t += red[w * 64 + tid];
        red[512 + tid] = t; }
    __syncthreads();
    const float lg = p.ln_g[ch], lb = p.ln_b[ch];
    u16* BOC = (u16*)((unsigned char*)p.out + 67108864 + 33554432);
#pragma unroll
    for (int k = 0; k < 32; ++k) { const float s = red[512 + k], q = red[512 + 32 + k];
        const float mu = s * (1.f / 512.f), var = fmaxf(q * (1.f / 512.f) - mu * mu, 0.f), rstd = rsqrtf(var + EPS_);
        const float y = (cv[k] - mu) * rstd * lg + lb;
        const u32 w = pk_bf16(y * fast_sigmoid(y), 0.f);
        BOC[(size_t)(t0 + k) * 512 + ch] = (u16)w; }
    __syncthreads();
}

__device__ __forceinline__ void phase_mix(const Params& p, unsigned char* lds) {
    float mq = 0.f, mk = 0.f, mmq = 0.f, mmk = 0.f;
    for (int i = 0; i < 64; ++i) { mq = fmaxf(mq, fabsf(p.qg[i])); mk = fmaxf(mk, fabsf(p.kg[i])); }
    for (int i = 0; i < 128; ++i) { mmq = fmaxf(mmq, fabsf(p.mqg[i])); mmk = fmaxf(mmk, fabsf(p.mkg[i])); }
    const float swa_bound = 8.f * mq * mk * 1.02f + 0.1f, mem_bound = 11.313708498984761f * mmq * mmk * 1.02f + 0.1f;
    if (MIX_MASK & 1) for (int it = blockIdx.x; it < 1024; it += gridDim.x) swa_item(p, it, lds, swa_bound);
    if (MIX_MASK & 2) for (int it = blockIdx.x; it < 512; it += gridDim.x) mem_item(p, it, lds, mem_bound);
    if (MIX_MASK & 4) for (int it = blockIdx.x; it < 512; it += gridDim.x) conv_item(p, it, lds);
}

__device__ __forceinline__ void phase_h2(const Params& p) {
    const int tid = threadIdx.x, lane = tid & 63, wave = tid >> 6;
    for (int r = blockIdx.x * 8 + wave; r < S_; r += gridDim.x * 8) rms_row(p.out + (size_t)r * D_, p.g_ffn, (u16*)(p.ws + WS_MERGED) + (size_t)r * D_, lane);
    const size_t gt = (size_t)blockIdx.x * NTHR + tid, gn = (size_t)gridDim.x * NTHR, n8 = (size_t)16384 * 2048 / 8;
    for (size_t i = gt; i < 2 * n8; i += gn) { const bool second = i >= n8; const size_t k = second ? i - n8 : i;
        const float* src = (second ? p.ev : p.eu) + k * 8; u16* dst = (u16*)(p.ws + (second ? WS_EV : WS_EU)) + k * 8;
        const f32x4 a = *(const f32x4*)src, b = *(const f32x4*)(src + 4);
        u32x4 w; w.x = pk_bf16(a[0], a[1]); w.y = pk_bf16(a[2], a[3]); w.z = pk_bf16(b[0], b[1]); w.w = pk_bf16(b[2], b[3]);
        *(u32x4*)dst = w; }
}

__device__ __forceinline__ void topk_item(const Params& p, int item, unsigned char* lds) {
    float* sc = (float*)lds;
    float* tv = (float*)lds;
    int* ti = (int*)(lds + 17408);
    const u16* __restrict__ Q = (const u16*)(p.ws + WS_Q); const u16* __restrict__ SK = (const u16*)(p.ws + WS_SK);
    const int tt = item >> 3, head = item & 7, t0 = tt * 128;
    const int tid = threadIdx.x, lane = tid & 63, wave = tid >> 6, fr = lane & 15, fq = lane >> 4;
    {
        const int side = wave & 1, quarter = wave >> 1;
        bf16x8 af[2][4];
#pragma unroll
        for (int mt = 0; mt < 2; ++mt)
#pragma unroll
            for (int ks = 0; ks < 4; ++ks) af[mt][ks] = *(const bf16x8*)(Q + (size_t)(t0 + quarter * 32 + mt * 16 + fr) * 2048 + head * 256 + side * 128 + ks * 32 + fq * 8);
        f32x4 acc[2][8];
#pragma unroll
        for (int nt = 0; nt < 8; ++nt) { acc[0][nt] = (f32x4){0.f, 0.f, 0.f, 0.f}; acc[1][nt] = (f32x4){0.f, 0.f, 0.f, 0.f}; }
#pragma unroll
        for (int nt = 0; nt < 8; ++nt)
#pragma unroll
            for (int ks = 0; ks < 4; ++ks) { const bf16x8 b = *(const bf16x8*)(SK + (size_t)((head * 2 + side) * 128 + nt * 16 + fr) * 128 + ks * 32 + fq * 8);
                acc[0][nt] = mfma16(af[0][ks], b, acc[0][nt]); acc[1][nt] = mfma16(af[1][ks], b, acc[1][nt]); }
#pragma unroll
        for (int mt = 0; mt < 2; ++mt)
#pragma unroll
            for (int nt = 0; nt < 8; ++nt)
#pragma unroll
                for (int j = 0; j < 4; ++j) sc[(side * 128 + quarter * 32 + mt * 16 + fq * 4 + j) * 129 + nt * 16 + fr] = acc[mt][nt][j];
    }
    __syncthreads();
    u32 v[16]; float val[16]; int tok = tid & 127, sd = (tid >> 7) & 1;
#pragma unroll
    for (int k = 0; k < 16; ++k) { v[k] = 0u; val[k] = 0.f; }
    if (tid < 256) { const float* row = sc + (sd * 128 + tok) * 129;
        for (int n = 0; n < 128; ++n) { u32 u = (mono_key(row[n]) & ~127u) | (u32)(127 - n);
#pragma unroll
            for (int k = 0; k < 16; ++k) { const u32 hi = max(v[k], u); u = min(v[k], u); v[k] = hi; } }
#pragma unroll
        for (int k = 0; k < 16; ++k) val[k] = row[127 - (int)(v[k] & 127u)]; }
    __syncthreads();
    if (tid < 256) {
#pragma unroll
        for (int k = 0; k < 16; ++k) { tv[(sd * 128 + tok) * 17 + k] = val[k]; ti[(sd * 128 + tok) * 17 + k] = 127 - (int)(v[k] & 127u); } }
    __syncthreads();
    if (tid < 128) { float v1[16], v2[16];
#pragma unroll
        for (int k = 0; k < 16; ++k) { v1[k] = tv[tid * 17 + k]; v2[k] = tv[(128 + tid) * 17 + k]; }
        u32 w[16];
#pragma unroll
        for (int k = 0; k < 16; ++k) w[k] = 0u;
#pragma unroll
        for (int i = 0; i < 16; ++i)
#pragma unroll
            for (int j = 0; j < 16; ++j) if ((i + 1) * (j + 1) <= 16) { u32 u = (mono_key(v1[i] + v2[j]) & ~255u) | (u32)(255 - (i * 16 + j));
#pragma unroll
                for (int k = 0; k < 16; ++k) { const u32 hi = max(w[k], u); u = min(w[k], u); w[k] = hi; } }
        float s[16]; int eid[16]; float m = -3.0e38f;
#pragma unroll
        for (int k = 0; k < 16; ++k) { const int cid = 255 - (int)(w[k] & 255u), i = cid >> 4, j = cid & 15;
            s[k] = tv[tid * 17 + i] + tv[(128 + tid) * 17 + j]; eid[k] = ti[tid * 17 + i] * 128 + ti[(128 + tid) * 17 + j]; m = fmaxf(m, s[k]); }
        float sum = 0.f;
#pragma unroll
        for (int k = 0; k < 16; ++k) { s[k] = __expf(s[k] - m); sum += s[k]; }
        const float inv = 1.f / sum;
        int* SI = (int*)(p.ws + WS_SI) + (size_t)(t0 + tid) * 128 + head * 16; float* SG = (float*)(p.ws + WS_SG) + (size_t)(t0 + tid) * 128 + head * 16;
#pragma unroll
        for (int k = 0; k < 16; k += 4) { *(int4*)(SI + k) = make_int4(eid[k], eid[k + 1], eid[k + 2], eid[k + 3]);
            *(f32x4*)(SG + k) = (f32x4){s[k] * inv, s[k + 1] * inv, s[k + 2] * inv, s[k + 3] * inv}; } }
    __syncthreads();
}

__device__ __forceinline__ void phase_peer(const Params& p) {
    const int tid = threadIdx.x, lane = tid & 63, wave = __builtin_amdgcn_readfirstlane(tid >> 6);
    const u16* __restrict__ H2 = (const u16*)(p.ws + WS_MERGED);
    const u16* __restrict__ EU = (const u16*)(p.ws + WS_EU); const u16* __restrict__ EV = (const u16*)(p.ws + WS_EV);
    const int* __restrict__ SI = (const int*)(p.ws + WS_SI); const float* __restrict__ SG = (const float*)(p.ws + WS_SG);
    for (int tb = blockIdx.x; tb < S_ / 8; tb += gridDim.x) {
        const int tok = tb * 8 + wave;
        u32x4 hx[4];
#pragma unroll
        for (int c = 0; c < 4; ++c) hx[c] = *(const u32x4*)(H2 + (size_t)tok * 2048 + c * 512 + lane * 8);
        const int i0 = SI[(size_t)tok * 128 + lane], i1 = SI[(size_t)tok * 128 + 64 + lane];
        const float g0 = SG[(size_t)tok * 128 + lane], g1 = SG[(size_t)tok * 128 + 64 + lane];
        float y[32];
#pragma unroll
        for (int k = 0; k < 32; ++k) y[k] = 0.f;
        u32x4 uA[4], vA[4], uB[4], vB[4];
#define PEER_LOAD(e, U, V) do { const int _e = (e); const int _id = __builtin_amdgcn_readlane(_e < 64 ? i0 : i1, _e & 63); \
            const u16* _pu = EU + (size_t)_id * 2048 + lane * 8; const u16* _pv = EV + (size_t)_id * 2048 + lane * 8; \
            _Pragma("unroll") for (int c = 0; c < 4; ++c) { U[c] = *(const u32x4*)(_pu + c * 512); V[c] = *(const u32x4*)(_pv + c * 512); } } while (0)
#define PEER_COMP(e, U, V) do { const int _e = (e); float a0 = 0.f, a1 = 0.f, a2 = 0.f, a3 = 0.f; \
            _Pragma("unroll") for (int c = 0; c < 4; ++c) { a0 = dot2bf(U[c].x, hx[c].x, a0); a1 = dot2bf(U[c].y, hx[c].y, a1); a2 = dot2bf(U[c].z, hx[c].z, a2); a3 = dot2bf(U[c].w, hx[c].w, a3); } \
            const float a = wave_sum((a0 + a1) + (a2 + a3)); const float gt_ = rdlane(_e < 64 ? g0 : g1, _e & 63); \
            const float act = 0.5f * a * (1.f + erff(a * 0.70710678118654752f)) * gt_; \
            _Pragma("unroll") for (int c = 0; c < 4; ++c) { \
                y[c * 8 + 0] += act * bf_lo(V[c].x); y[c * 8 + 1] += act * bf_hi(V[c].x); y[c * 8 + 2] += act * bf_lo(V[c].y); y[c * 8 + 3] += act * bf_hi(V[c].y); \
                y[c * 8 + 4] += act * bf_lo(V[c].z); y[c * 8 + 5] += act * bf_hi(V[c].z); y[c * 8 + 6] += act * bf_lo(V[c].w); y[c * 8 + 7] += act * bf_hi(V[c].w); } } while (0)
        PEER_LOAD(0, uA, vA);
        for (int e = 0; e < 128; e += 2) {
            PEER_LOAD(e + 1, uB, vB);
            PEER_COMP(e, uA, vA);
            if (e + 2 < 128) PEER_LOAD(e + 2, uA, vA);
            PEER_COMP(e + 1, uB, vB);
        }
#undef PEER_LOAD
#undef PEER_COMP
        float* op = p.out + (size_t)tok * 2048 + lane * 8;
#pragma unroll
        for (int c = 0; c < 4; ++c) { f32x4 a = *(const f32x4*)(op + c * 512), b = *(const f32x4*)(op + c * 512 + 4);
            a[0] += y[c * 8 + 0]; a[1] += y[c * 8 + 1]; a[2] += y[c * 8 + 2]; a[3] += y[c * 8 + 3]; b[0] += y[c * 8 + 4]; b[1] += y[c * 8 + 5]; b[2] += y[c * 8 + 6]; b[3] += y[c * 8 + 7];
            *(f32x4*)(op + c * 512) = a; *(f32x4*)(op + c * 512 + 4) = b; }
    }
}

constexpr int N_PHASES = 9;
#ifndef PH_MASK
#define PH_MASK 0x1ff
#endif
__device__ __forceinline__ void run_gemms(const Params& p, unsigned char* lds, const int j0, const int j1) {
    unsigned char* ws = p.ws;
    for (int j = j0; j < j1; ++j) {
        pg8::Gemm g; EpiU E; E.mode = 0; E.O = nullptr; E.Of = nullptr; E.X = nullptr; E.G = nullptr; E.ldc = 0; E.ldg = INW; E.sig_from = 1 << 30; E.first = 0;
        u16* proj = (u16*)(ws + WS_PROJ); u16* merged = (u16*)(ws + WS_MERGED);
        const u16* BOA = (const u16*)((unsigned char*)p.out + 67108864); const u16* BOC = BOA + (size_t)S_ * 1024; const u16* BOM = BOC + (size_t)S_ * 512;
        if (j == 0) { g = pg8::Gemm{(const u16*)p.out, (const u16*)(ws + WS_WIN_T), S_, INW, D_}; E.O = proj; E.ldc = INW; E.sig_from = C_GA; }
        else if (j == 1) { g = pg8::Gemm{(const u16*)(ws + WS_MEMN), (const u16*)(ws + WS_WKV_T), 256, 1024, D_}; E.O = (u16*)(ws + WS_MEMKV); E.ldc = 1024; }
        else if (j == 2) { g = pg8::Gemm{BOA, (const u16*)(ws + WS_WA_T), S_, D_, 1024}; E.mode = 1; E.O = merged; E.ldc = D_; E.G = proj + C_GA; E.first = 1; }
        else if (j == 3) { g = pg8::Gemm{BOC, (const u16*)(ws + WS_WC_T), S_, D_, 512}; E.mode = 1; E.O = merged; E.ldc = D_; E.G = proj + C_GC; }
        else if (j == 4) { g = pg8::Gemm{BOM, (const u16*)(ws + WS_WM_T), S_, D_, 512}; E.mode = 1; E.O = merged; E.ldc = D_; E.G = proj + C_GM; }
        else if (j == 5) { g = pg8::Gemm{merged, (const u16*)(ws + WS_WOUT_T), S_, D_, D_}; E.mode = 2; E.Of = p.out; E.X = p.x; E.ldc = D_; }
        else { g = pg8::Gemm{merged, (const u16*)(ws + WS_WQ_T), S_, D_, D_}; E.O = (u16*)(ws + WS_Q); E.ldc = D_; }
        pg8::StaticOrder So; So.init(g.M, g.N, (int)gridDim.x, (int)blockIdx.x);
        pg8::gemm_phase<EpiU, pg8::StaticOrder>((PG8_LAS unsigned char*)lds, g, So, E, nullptr);
        __syncthreads();
    }
}
__global__ void __launch_bounds__(NTHR, 2) hybrid_fwd(Params p) {
    extern __shared__ __attribute__((aligned(16))) unsigned char lds[];
    cg::grid_group grid = cg::this_grid();
#define IN(k) (p.ph_lo <= (k) && (k) < p.ph_hi)
#define SEAM(k) do { if (IN(k) && IN((k) + 1)) grid.sync(); } while (0)
    if ((PH_MASK & 1) && IN(0)) phase_prep(p, lds);
    SEAM(0);
    if ((PH_MASK & 2) && IN(1)) run_gemms(p, lds, 0, 2);
    SEAM(1);
    if ((PH_MASK & 4) && IN(2)) phase_mix(p, lds);
    SEAM(2);
    if ((PH_MASK & 8) && IN(3)) run_gemms(p, lds, 2, 5);
    SEAM(3);
    if ((PH_MASK & 16) && IN(4)) run_gemms(p, lds, 5, 6);
    SEAM(4);
    if ((PH_MASK & 32) && IN(5)) phase_h2(p);
    SEAM(5);
    if ((PH_MASK & 64) && IN(6)) run_gemms(p, lds, 6, 7);
    SEAM(6);
    if ((PH_MASK & 128) && IN(7)) for (int it = blockIdx.x; it < 1024; it += gridDim.x) topk_item(p, it, lds);
    SEAM(7);
    if ((PH_MASK & 256) && IN(8)) phase_peer(p);
#undef IN
#undef SEAM
}

#ifndef MK_LAUNCHES
#define MK_LAUNCHES 1
#endif
extern "C" void kernel_launch(void* const* d_in, const int* in_sizes, int n_in, void* d_out, int out_size, void* d_ws, size_t ws_size, hipStream_t stream) {
    static int grid = 0;
    if (grid == 0) {
        if (n_in != 25 || out_size != S_ * D_ || ws_size < WS_END) { fprintf(stderr, "kernel_launch: unexpected shapes (n_in %d out %d ws %zu need %zu)\n", n_in, out_size, ws_size, (size_t)WS_END); grid = -1; return; }
        int dev = 0, cus = 0, per_cu = 0;
        hipGetDevice(&dev); hipDeviceGetAttribute(&cus, hipDeviceAttributeMultiprocessorCount, dev);
        if (hipFuncSetAttribute((const void*)hybrid_fwd, hipFuncAttributeMaxDynamicSharedMemorySize, LDS_BYTES) != hipSuccess) { fprintf(stderr, "kernel_launch: hipFuncSetAttribute failed\n"); grid = -1; return; }
        if (hipOccupancyMaxActiveBlocksPerMultiprocessor(&per_cu, (const void*)hybrid_fwd, NTHR, LDS_BYTES) != hipSuccess || per_cu < 1) { fprintf(stderr, "kernel_launch: occupancy query gave %d\n", per_cu); per_cu = 1; }
        (void)hipGetLastError();
        grid = cus * per_cu;
    }
    if (grid < 0) return;
    Params p{};
    p.x = (const float*)d_in[0]; p.mem = (const float*)d_in[1]; p.pos = (const int*)d_in[2]; p.g_mix = (const float*)d_in[3]; p.w_in = (const float*)d_in[4];
    p.qg = (const float*)d_in[5]; p.kg = (const float*)d_in[6]; p.sinks = (const float*)d_in[7]; p.w_attn_o = (const float*)d_in[8]; p.dw_w = (const float*)d_in[9];
    p.dw_b = (const float*)d_in[10]; p.ln_g = (const float*)d_in[11]; p.ln_b = (const float*)d_in[12]; p.w_conv_o = (const float*)d_in[13]; p.g_mem = (const float*)d_in[14];
    p.w_mem_kv = (const float*)d_in[15]; p.mqg = (const float*)d_in[16]; p.mkg = (const float*)d_in[17]; p.w_mem_o = (const float*)d_in[18]; p.w_out = (const float*)d_in[19];
    p.g_ffn = (const float*)d_in[20]; p.w_query = (const float*)d_in[21]; p.sub_keys = (const float*)d_in[22]; p.eu = (const float*)d_in[23]; p.ev = (const float*)d_in[24];
    p.out = (float*)d_out; p.ws = (unsigned char*)d_ws;
#if MK_LAUNCHES == 1
    p.ph_lo = 0; p.ph_hi = N_PHASES;
    void* args[] = {&p};
    hipError_t e = hipLaunchCooperativeKernel((const void*)hybrid_fwd, dim3(grid), dim3(NTHR), args, LDS_BYTES, stream);
    if (e != hipSuccess) fprintf(stderr, "kernel_launch: cooperative launch failed: %s (grid %d)\n", hipGetErrorString(e), grid);
#else
    for (int ph = 0; ph < N_PHASES; ++ph) { p.ph_lo = ph; p.ph_hi = ph + 1; hipLaunchKernelGGL(hybrid_fwd, dim3(grid), dim3(NTHR), LDS_BYTES, stream, p); }
#endif
}
```

```cpp
#include <hip/hip_runtime.h>
#include <hip/hip_cooperative_groups.h>
#include <cstdio>
namespace cg = cooperative_groups;
namespace pg8 {
#define PG8_LAS __attribute__((address_space(3)))
typedef unsigned short bf16_t;
typedef short bf16x8 __attribute__((ext_vector_type(8)));
typedef float f32x4 __attribute__((ext_vector_type(4)));
typedef unsigned u32x4 __attribute__((ext_vector_type(4)));
constexpr int BM = 256, BK = 64, HALF = 128, HTB = HALF * BK * 2  , STAGE_BYTES = 8 * HTB, NXCD = 8, WGM = 4;

__host__ __device__ __forceinline__ int lds_byte(int r, int c) { const int st = (r >> 4) * 2 + (c >> 5), rr = r & 15, cc = c & 31, ob = rr * 64 + cc * 2; return st * 1024 + (ob ^ (((ob >> 9) & 1) << 5)); }
__host__ __device__ __forceinline__ void stage_rc(int b, int& R, int& C) { const int st = b / 1024, sb = b % 1024, swz = sb ^ (((sb >> 9) & 1) << 5); R = (st >> 1) * 16 + swz / 64; C = (st & 1) * 32 + (swz % 64) / 2; }
__host__ __device__ __forceinline__ int perm32(int rho) { const int n = rho >> 4, i = rho & 15; return 8 * (i >> 2) + 4 * n + (i & 3); }

struct Unit { int pm, pn; };
struct Gemm { const bf16_t* A; const bf16_t* Bt; int M, N, K; };

struct StaticOrder {
    int nM, nN, nwg, G, c;
    __host__ __device__ void init(int M, int N, int G_, int c_) { nM = M / BM; nN = N / BM; nwg = nM * nN; G = G_; c = c_; }
    __host__ __device__ bool next(int i, Unit& u) const {
        const long L = (long)i * G + c; if (L >= nwg) return false;
        int wgid = (int)L; { const int q = nwg / NXCD, r = nwg % NXCD, xcd = wgid % NXCD, off = wgid / NXCD; wgid = (xcd < r ? xcd * (q + 1) : r * (q + 1) + (xcd - r) * q) + off; }
        const int nig = WGM * nN, gid = wgid / nig, fm = gid * WGM, gsz = (nM - fm) < WGM ? (nM - fm) : WGM;
        u.pm = fm + ((wgid % nig) % gsz); u.pn = (wgid % nig) / gsz; return true;
    }
    __device__ __forceinline__ void a_ready(const Unit&) const {}
    __device__ __forceinline__ void done(const Unit&) const {}
};
__device__ __forceinline__ unsigned cvt_pk_bf16(float lo, float hi) { unsigned r; asm volatile("v_cvt_pk_bf16_f32 %0, %1, %2" : "=v"(r) : "v"(lo), "v"(hi)); return r; }
typedef float f32x2 __attribute__((ext_vector_type(2)));
template <class Epi, class Sched, bool STAMP = false>
__device__ __forceinline__ void gemm_phase(PG8_LAS unsigned char* lds, const Gemm g, const Sched& S, const Epi& E, unsigned long long* stamps) {
    const int tid = threadIdx.x, wid = __builtin_amdgcn_readfirstlane(tid >> 6), lane = tid & 63, wr = wid >> 2, wc = wid & 3, fr = lane & 15, fq = lane >> 4;
    const int K = g.K, nt = K / BK;
    int ts_lo = 0, ts_hi = 0, nts = 0; const unsigned long long rt_entry = STAMP ? (unsigned long long)wall_clock64() : 0ull;
#define PG8_STAMP() do { if (STAMP && wid == 0 && nts < 64) { const unsigned long long _c = (unsigned long long)clock64(); \
        ts_lo = (lane == nts) ? (int)(unsigned)_c : ts_lo; ts_hi = (lane == nts) ? (int)(unsigned)(_c >> 32) : ts_hi; ++nts; } } while (0)
    PG8_STAMP();
    unsigned voffA[2], voffB[2];
#pragma unroll
    for (int i = 0; i < 2; ++i) { int R, C; stage_rc(tid * 16 + i * 8192, R, C); const int Rb = ((R & ~31) + perm32(R & 31));
        voffA[i] = (unsigned)(R * K + C) * 2u; voffB[i] = (unsigned)(Rb * K + C) * 2u; }
    const size_t kstep = (size_t)(BK * 2);
    const size_t hstep = (size_t)HALF * K * 2;
    const size_t tstep = 2 * hstep;
    const unsigned ldsw = (unsigned)wid * 1024u;
    const int aoff = lds_byte(wr * 64 + fr, fq * 8), boff = lds_byte(wc * 32 + fr, fq * 8);
#define PG8_SA(b, h) (((b) * 2 + (h)) * HTB)
#define PG8_SB(b, h) ((4 + (b) * 2 + (h)) * HTB)
#define PG8_STAGE(bufoff, gbase, voff) do { _Pragma("unroll") for (int _i = 0; _i < 2; ++_i) \
        __builtin_amdgcn_global_load_lds((const unsigned*)((const char*)(gbase) + (voff)[_i]), (PG8_LAS unsigned*)(lds + (bufoff) + ldsw + _i * 8192), 16, 0, 0); } while (0)
#define PG8_LDA(dst, b, h) do { _Pragma("unroll") for (int m = 0; m < 4; ++m) _Pragma("unroll") for (int k = 0; k < 2; ++k) dst[m][k] = *(const PG8_LAS bf16x8*)(lds + PG8_SA(b, h) + aoff + m * 2048 + k * 1024); } while (0)
#define PG8_LDB(dst, b, h) do { _Pragma("unroll") for (int n = 0; n < 2; ++n) _Pragma("unroll") for (int k = 0; k < 2; ++k) dst[n][k] = *(const PG8_LAS bf16x8*)(lds + PG8_SB(b, h) + boff + n * 2048 + k * 1024); } while (0)
#define PG8_MMA(ai, bj, At, Bt) do { __builtin_amdgcn_s_setprio(1); _Pragma("unroll") for (int m = 0; m < 4; ++m) _Pragma("unroll") for (int n = 0; n < 2; ++n) _Pragma("unroll") for (int k = 0; k < 2; ++k) \
        acc[ai][bj][m][n] = __builtin_amdgcn_mfma_f32_16x16x32_bf16(Bt[n][k], At[m][k], acc[ai][bj][m][n], 0, 0, 0); __builtin_amdgcn_s_setprio(0); } while (0)
#define PG8_WAIT_V(n) asm volatile("s_waitcnt vmcnt(" #n ")" ::: "memory")
#define PG8_WAIT_L(n) asm volatile("s_waitcnt lgkmcnt(" #n ")" ::: "memory")
#define PG8_BAR __builtin_amdgcn_s_barrier()
#define PG8_SCHED __builtin_amdgcn_sched_barrier(0)
    Unit cur, nxt; int ui = 0;
    if (!S.next(0, cur)) return;
    f32x4 acc[2][2][4][2];
#pragma unroll
    for (int a = 0; a < 2; ++a)
#pragma unroll
        for (int b = 0; b < 2; ++b)
#pragma unroll
            for (int m = 0; m < 4; ++m)
#pragma unroll
                for (int n = 0; n < 2; ++n) acc[a][b][m][n] = (f32x4){0.f, 0.f, 0.f, 0.f};
    bf16x8 At[4][2], B0[2][2], B1[2][2];
    const char* cA = (const char*)g.A + (size_t)cur.pm * tstep; const char* cB = (const char*)g.Bt + (size_t)cur.pn * tstep;
    S.a_ready(cur);
    PG8_STAGE(PG8_SB(0, 0), cB, voffB); PG8_STAGE(PG8_SA(0, 0), cA, voffA); PG8_STAGE(PG8_SB(0, 1), cB + hstep, voffB); PG8_STAGE(PG8_SA(0, 1), cA + hstep, voffA);
    if (wr == 1) PG8_BAR;
    PG8_WAIT_V(4); PG8_BAR;
    PG8_STAGE(PG8_SB(1, 0), cB + kstep, voffB); PG8_STAGE(PG8_SA(1, 0), cA + kstep, voffA); PG8_STAGE(PG8_SB(1, 1), cB + hstep + kstep, voffB);
    PG8_WAIT_V(6); PG8_BAR;
    PG8_STAMP();
    for (;;) {
        const bool has_next = S.next(ui + 1, nxt);
        const char* nA = has_next ? (const char*)g.A + (size_t)nxt.pm * tstep : cA; const char* nB = has_next ? (const char*)g.Bt + (size_t)nxt.pn * tstep : cB;
        for (int t = 0; t < nt; t += 2) {
            const bool last = (t == nt - 2);
            const char* a1 = cA + (size_t)(t + 1) * kstep;
            const char* a2 = last ? nA : cA + (size_t)(t + 2) * kstep; const char* b2 = last ? nB : cB + (size_t)(t + 2) * kstep;
            const char* a3 = a2 + kstep; const char* b3 = b2 + kstep;
            E.hook(acc, cur, t, wr, wc, fr, fq);
            if (last && has_next) S.a_ready(nxt);
            PG8_LDB(B0, 0, 0); PG8_SCHED; PG8_LDA(At, 0, 0); PG8_STAGE(PG8_SA(1, 1), a1 + hstep, voffA);
            PG8_WAIT_L(8); PG8_BAR; PG8_WAIT_L(0); PG8_MMA(0, 0, At, B0); PG8_BAR; PG8_SCHED;
            PG8_LDB(B1, 0, 1); PG8_STAGE(PG8_SB(0, 0), b2, voffB);
            PG8_BAR; PG8_WAIT_L(0); PG8_MMA(0, 1, At, B1); PG8_BAR;
            PG8_LDA(At, 0, 1); PG8_STAGE(PG8_SA(0, 0), a2, voffA);
            PG8_BAR; PG8_WAIT_L(0); PG8_MMA(1, 0, At, B0); PG8_BAR; PG8_SCHED;
            PG8_STAGE(PG8_SB(0, 1), b2 + hstep, voffB);
            PG8_WAIT_V(6); PG8_BAR; PG8_MMA(1, 1, At, B1); PG8_BAR;
            PG8_LDB(B0, 1, 0); PG8_SCHED; PG8_LDA(At, 1, 0); PG8_STAGE(PG8_SA(0, 1), a2 + hstep, voffA);
            PG8_WAIT_L(8); PG8_BAR; PG8_WAIT_L(0); PG8_MMA(0, 0, At, B0); PG8_BAR; PG8_SCHED;
            PG8_LDB(B1, 1, 1); PG8_STAGE(PG8_SB(1, 0), b3, voffB);
            PG8_BAR; PG8_WAIT_L(0); PG8_MMA(0, 1, At, B1); PG8_BAR;
            PG8_LDA(At, 1, 1); PG8_STAGE(PG8_SA(1, 0), a3, voffA);
            PG8_BAR; PG8_WAIT_L(0); PG8_MMA(1, 0, At, B0); PG8_BAR; PG8_SCHED;
            PG8_STAGE(PG8_SB(1, 1), b3 + hstep, voffB);
            PG8_WAIT_V(6); PG8_BAR; PG8_MMA(1, 1, At, B1); PG8_BAR;
        }
        PG8_STAMP();
        if constexpr (!Epi::AFTER_DRAIN) { E(acc, cur, wr, wc, fr, fq); S.done(cur); }
        PG8_STAMP();
        if (!has_next) break;
#pragma unroll
        for (int a = 0; a < 2; ++a)
#pragma unroll
            for (int b = 0; b < 2; ++b)
#pragma unroll
                for (int m = 0; m < 4; ++m)
#pragma unroll
                    for (int n = 0; n < 2; ++n) acc[a][b][m][n] = (f32x4){0.f, 0.f, 0.f, 0.f};
        cur = nxt; cA = nA; cB = nB; ++ui;
    }
    PG8_WAIT_V(0);
    if (wr == 0) PG8_BAR;
    PG8_BAR;
    if constexpr (Epi::AFTER_DRAIN) { E.fused(acc, cur, wr, wc, fr, fq, lds, wid, lane); S.done(cur); }
    PG8_STAMP();
    if (STAMP && wid == 0) { stamps[lane] = lane < nts ? (((unsigned long long)(unsigned)ts_hi << 32) | (unsigned)ts_lo) : 0ull;
        if (lane == 62) stamps[62] = rt_entry; if (lane == 63) stamps[63] = (unsigned long long)wall_clock64(); }
#undef PG8_STAMP
#undef PG8_SA
#undef PG8_SB
#undef PG8_STAGE
#undef PG8_LDA
#undef PG8_LDB
#undef PG8_MMA
#undef PG8_WAIT_V
#undef PG8_WAIT_L
#undef PG8_BAR
#undef PG8_SCHED
}
}

#define XB_TMO      128
#define XB_XCNT(j)  (256  + 64 * (j))
#define XB_XSUB(j)  (1280 + 64 * (j))
#define XB_XGEN(j)  (2304 + 64 * (j))
#define XB_TOP      3328
#define XB_TOPGEN   3392
#define XCD_BAR_WORDS 3456
#define XB_SPIN_CAP (1u << 18)
#define LAS __attribute__((address_space(3)))

__device__ __forceinline__ unsigned xb_ld(unsigned* p)              { return __hip_atomic_load(p, __ATOMIC_RELAXED, __HIP_MEMORY_SCOPE_AGENT); }
__device__ __forceinline__ unsigned xb_add(unsigned* p, unsigned v) { return __hip_atomic_fetch_add(p, v, __ATOMIC_RELAXED, __HIP_MEMORY_SCOPE_AGENT); }
__device__ __forceinline__ unsigned xb_xcc_id() { return (unsigned)__builtin_amdgcn_s_getreg((3 << 11) | 20) & 0xFu; }
#define XB_SPIN(cond, bar) do { unsigned _sp = 0; while (cond) { __builtin_amdgcn_s_sleep(1); \
    if ((++_sp & 255u) == 0u) { if (xb_ld(&(bar)[XB_TMO])) break; if (_sp > XB_SPIN_CAP) { atomicAdd(&(bar)[XB_TMO], 1u); break; } } } } while (0)

struct XcdBarrier {
    unsigned* bar; unsigned x;
    volatile LAS unsigned* st;
};

__device__ __forceinline__ XcdBarrier xcd_barrier_post(unsigned* bar, volatile LAS unsigned* st) {
    XcdBarrier b; b.bar = bar; b.x = xb_xcc_id(); b.st = st;
    if (threadIdx.x == 0) (void)xb_add(&bar[XB_XCNT(b.x)], 1u);
    return b;
}
__device__ __forceinline__ void xcd_barrier_complete(unsigned* bar, unsigned x, unsigned& nloc, unsigned& nx) {
    const unsigned G = gridDim.x * gridDim.y * gridDim.z;
    unsigned sum, cnt, mine, sp = 0u;
    for (;;) {
        sum = 0u; cnt = 0u; mine = 0u;
#pragma unroll
        for (unsigned j = 0; j < 16; ++j) { const unsigned c = xb_ld(&bar[XB_XCNT(j)]); sum += c; cnt += (c > 0u) ? 1u : 0u; mine = (j == x) ? c : mine; }
        if (sum == G) break;
        __builtin_amdgcn_s_sleep(1);
        if ((++sp & 255u) == 0u) { if (xb_ld(&bar[XB_TMO])) break; if (sp > XB_SPIN_CAP) { atomicAdd(&bar[XB_TMO], 1u); break; } }
    }
    nloc = mine > 0u ? mine : 1u; nx = cnt > 0u ? cnt : 1u;
}

__device__ __forceinline__ void xcd_barrier(const XcdBarrier& b) {
    asm volatile("s_waitcnt vmcnt(0)" ::: "memory");
    __syncthreads();
    if (threadIdx.x == 0) {
        unsigned* bar = b.bar;
        __builtin_amdgcn_s_waitcnt(0);
        unsigned nloc = b.st[0], nx = b.st[1];
        if (nloc == 0u) { xcd_barrier_complete(bar, b.x, nloc, nx); b.st[0] = nloc; b.st[1] = nx; }
        const unsigned old = xb_add(&bar[XB_XSUB(b.x)], 1u);
        const unsigned gen = old / nloc;
        if (old + 1u == (gen + 1u) * nloc) {
            __builtin_amdgcn_fence(__ATOMIC_RELEASE, "agent");
            asm volatile("s_waitcnt vmcnt(0)" ::: "memory");
            const unsigned og = xb_add(&bar[XB_TOP], 1u);
            const unsigned tg = og / nx;
            if (og + 1u == (tg + 1u) * nx) xb_add(&bar[XB_TOPGEN], 1u);
            else XB_SPIN(xb_ld(&bar[XB_TOPGEN]) == tg, bar);
            __builtin_amdgcn_fence(__ATOMIC_ACQUIRE, "agent");
            xb_add(&bar[XB_XGEN(b.x)], 1u);
            asm volatile("s_waitcnt vmcnt(0)" ::: "memory");
        } else {
            XB_SPIN(xb_ld(&bar[XB_XGEN(b.x)]) == gen, bar);
            __builtin_amdgcn_fence(__ATOMIC_ACQUIRE, "agent");
            asm volatile("s_waitcnt vmcnt(0)" ::: "memory");
        }
    }
    __syncthreads();
}

typedef unsigned short u16;
typedef unsigned int u32;
typedef short bf16x8 __attribute__((ext_vector_type(8)));
typedef float f32x4 __attribute__((ext_vector_type(4)));
typedef u32 u32x4 __attribute__((ext_vector_type(4)));
typedef u32 u32x2 __attribute__((ext_vector_type(2)));
typedef __bf16 bf16x2_t __attribute__((ext_vector_type(2)));

constexpr int S_ = 16384, D_ = 2048, INW = 9216;
constexpr int C_Q = 0, C_K = 1024, C_V = 1280, C_CA = 1536, C_CB = 2048, C_MQ = 2560, C_GA = 3072, C_GC = 5120, C_GM = 7168;
constexpr float EPS_ = 1e-6f, LOG2E = 1.4426950408889634f;
constexpr int LDS_BYTES = 155648, NTHR = 512;

constexpr size_t WS_WIN_T = 4096;
constexpr size_t WS_WA_T = WS_WIN_T + (size_t)INW * D_ * 2;
constexpr size_t WS_WC_T = WS_WA_T + (size_t)2048 * 1024 * 2;
constexpr size_t WS_WM_T = WS_WC_T + (size_t)2048 * 512 * 2;
constexpr size_t WS_WKV_T = WS_WM_T + (size_t)2048 * 512 * 2;
constexpr size_t WS_WOUT_T = WS_WKV_T + (size_t)1024 * 2048 * 2;
constexpr size_t WS_WQ_T = WS_WOUT_T + (size_t)2048 * 2048 * 2;
constexpr size_t WS_SK = WS_WQ_T + (size_t)2048 * 2048 * 2;
constexpr size_t WS_MEMN = WS_SK + (size_t)16 * 128 * 128 * 2;
constexpr size_t WS_MEMKV = WS_MEMN + (size_t)256 * 2048 * 2;
constexpr size_t WS_COS = WS_MEMKV + (size_t)256 * 1024 * 2;
constexpr size_t WS_SIN = WS_COS + (size_t)S_ * 32 * 4;
constexpr size_t WS_MERGED = WS_SIN + (size_t)S_ * 32 * 4;
constexpr size_t WS_PROJ = WS_MERGED + (size_t)S_ * D_ * 2;
constexpr size_t WS_EV = WS_PROJ + (size_t)16384 * 2048;
constexpr size_t WS_Q = WS_EV + (size_t)16384 * 2048;
constexpr size_t WS_SI = WS_Q + (size_t)S_ * 2048 * 2;
constexpr size_t WS_SG = WS_SI + (size_t)S_ * 128 * 4;
constexpr size_t WS_SGU = WS_SG + (size_t)S_ * 128 * 4;
constexpr size_t WS_END = WS_PROJ + (size_t)S_ * INW * 2;
constexpr size_t WS_BAR = WS_END;
constexpr size_t WS_EU = WS_BAR + 16384;
constexpr size_t WS_SUI = WS_EU + (size_t)16384 * 3072;
constexpr size_t WS_SVI = WS_SUI + (size_t)16384 * 4;
constexpr size_t WS_TOTAL = WS_SVI + (size_t)16384 * 4;
static_assert(WS_SGU + (size_t)S_ * 128 * 4 <= WS_END, "peer scratch must fit the dead proj region");

#define ROWMAP(r) ((gridDim.x == 256) ? ((((r) >> 3) & 7) * 2048 + (((r) & 7) | (((r) >> 6) << 3))) : (r))
struct Params {
    const float* x; const float* mem; const int* pos; const float* g_mix; const float* w_in; const float* qg; const float* kg; const float* sinks;
    const float* w_attn_o; const float* dw_w; const float* dw_b; const float* ln_g; const float* ln_b; const float* w_conv_o; const float* g_mem;
    const float* w_mem_kv; const float* mqg; const float* mkg; const float* w_mem_o; const float* w_out; const float* g_ffn; const float* w_query;
    const float* sub_keys; const float* eu; const float* ev;
    float* out; unsigned char* ws; int ph_lo, ph_hi;
};

__device__ __forceinline__ u32 pk_bf16(float lo, float hi) { u32 r; asm("v_cvt_pk_bf16_f32 %0, %1, %2" : "=v"(r) : "v"(lo), "v"(hi)); return r; }
__device__ __forceinline__ float bf_lo(u32 w) { return __uint_as_float(w << 16); }
__device__ __forceinline__ float bf_hi(u32 w) { return __uint_as_float(w & 0xffff0000u); }
__device__ __forceinline__ float fast_sigmoid(float x) { return __builtin_amdgcn_rcpf(1.f + __builtin_amdgcn_exp2f(-x * LOG2E)); }
template <int CTRL> __device__ __forceinline__ float dppf(float v) { return __builtin_bit_cast(float, __builtin_amdgcn_update_dpp(0, __builtin_bit_cast(int, v), CTRL, 0xf, 0xf, true)); }
__device__ __forceinline__ float row_sum16(float v) { v += dppf<0xB1>(v); v += dppf<0x4E>(v); v += dppf<0x141>(v); v += dppf<0x140>(v); return v; }
__device__ __forceinline__ float grp8_sum(float v) { v += dppf<0xB1>(v); v += dppf<0x4E>(v); v += dppf<0x141>(v); return v; }
__device__ __forceinline__ float shx(float v, int lane, int m) { return __builtin_bit_cast(float, __builtin_amdgcn_ds_bpermute((lane ^ m) << 2, __builtin_bit_cast(int, v))); }
__device__ __forceinline__ float rdlane(float v, int l) { return __builtin_bit_cast(float, __builtin_amdgcn_readlane(__builtin_bit_cast(int, v), l)); }
__device__ __forceinline__ float wave_sum(float v) { v = row_sum16(v); return (rdlane(v, 0) + rdlane(v, 16)) + (rdlane(v, 32) + rdlane(v, 48)); }
__device__ __forceinline__ float dot2bf(u32 a, u32 b, float acc) { return __builtin_amdgcn_fdot2_f32_bf16(__builtin_bit_cast(bf16x2_t, a), __builtin_bit_cast(bf16x2_t, b), acc, false); }
__device__ __forceinline__ f32x4 mfma16(bf16x8 a, bf16x8 b, f32x4 c) { return __builtin_amdgcn_mfma_f32_16x16x32_bf16(a, b, c, 0, 0, 0); }
template <int CTRL> __device__ __forceinline__ float dppmax(float v) { return fmaxf(v, dppf<CTRL>(v)); }
__device__ __forceinline__ float wave_max(float v) { v = dppmax<0xB1>(v); v = dppmax<0x4E>(v); v = dppmax<0x141>(v); v = dppmax<0x140>(v); return fmaxf(fmaxf(rdlane(v, 0), rdlane(v, 16)), fmaxf(rdlane(v, 32), rdlane(v, 48))); }
typedef float f32x2 __attribute__((ext_vector_type(2)));
typedef float v16f __attribute__((ext_vector_type(16)));
typedef float v32f __attribute__((ext_vector_type(32)));
typedef unsigned v6u __attribute__((ext_vector_type(6)));
#ifndef FP6_INTERLEAVED
#define FP6_INTERLEAVED 1
#endif
__device__ __forceinline__ u32 mono_key(float x) { u32 u = __float_as_uint(x); return (u & 0x80000000u) ? ~u : (u | 0x80000000u); }

template <bool HOOKED> struct EpiU {
    static constexpr bool PERM = true, AFTER_DRAIN = false;
    int mode;
    u16* O; float* Of; const float* X; const u16* G; int ldc; int ldg; int sig_from;
    __device__ __forceinline__ void hook(pg8::f32x4 (&acc)[2][2][4][2], const pg8::Unit& u, int t, int wr, int wc, int fr, int fq) const {
        if (!HOOKED) return;
        if (t != 16 && t != 24) return;
        int z = 0; asm volatile("" : "+v"(z));
        const unsigned char* gc = (const unsigned char*)(G + (t == 16 ? 0 : 2048));
        const int row0 = u.pm * 256 + wr * 64 + fr + z, col0 = u.pn * 256 + wc * 32 + 8 * fq;
        const u32 off0 = ((u32)row0 * (u32)INW + (u32)col0) * 2u;
#pragma unroll
        for (int ai = 0; ai < 2; ++ai) {
            u32x4 ga[4][2], gb[4][2];
#pragma unroll
            for (int m = 0; m < 4; ++m)
#pragma unroll
                for (int bj = 0; bj < 2; ++bj) { const unsigned char* gp = gc + (off0 + (u32)(((ai * 128 + m * 16) * INW + bj * 128) * 2));
                    ga[m][bj] = *(const u32x4*)gp; gb[m][bj] = *(const u32x4*)(gp + 4096); }
#pragma unroll
            for (int m = 0; m < 4; ++m)
#pragma unroll
                for (int bj = 0; bj < 2; ++bj) { const u32x4 a = ga[m][bj], b = gb[m][bj];
                    acc[ai][bj][m][0][0] *= bf_lo(a.x) * __builtin_amdgcn_rcpf(bf_lo(b.x)); acc[ai][bj][m][0][1] *= bf_hi(a.x) * __builtin_amdgcn_rcpf(bf_hi(b.x));
                    acc[ai][bj][m][0][2] *= bf_lo(a.y) * __builtin_amdgcn_rcpf(bf_lo(b.y)); acc[ai][bj][m][0][3] *= bf_hi(a.y) * __builtin_amdgcn_rcpf(bf_hi(b.y));
                    acc[ai][bj][m][1][0] *= bf_lo(a.z) * __builtin_amdgcn_rcpf(bf_lo(b.z)); acc[ai][bj][m][1][1] *= bf_hi(a.z) * __builtin_amdgcn_rcpf(bf_hi(b.z));
                    acc[ai][bj][m][1][2] *= bf_lo(a.w) * __builtin_amdgcn_rcpf(bf_lo(b.w)); acc[ai][bj][m][1][3] *= bf_hi(a.w) * __builtin_amdgcn_rcpf(bf_hi(b.w)); }
            __builtin_amdgcn_sched_barrier(0); }
    }
    __device__ __forceinline__ void operator()(const pg8::f32x4 (&acc)[2][2][4][2], const pg8::Unit& u, int wr, int wc, int fr, int fq) const {
        const int row0 = u.pm * 256 + wr * 64 + fr, col0 = u.pn * 256 + wc * 32 + 8 * fq;
        if (mode == 0) {
            const bool sg = (u.pn * 256) >= sig_from;
#pragma unroll
            for (int ai = 0; ai < 2; ++ai)
#pragma unroll
                for (int m = 0; m < 4; ++m) { u16* rowp = O + (size_t)(row0 + ai * 128 + m * 16) * ldc + col0;
#pragma unroll
                    for (int bj = 0; bj < 2; ++bj) { f32x4 v0 = acc[ai][bj][m][0], v1 = acc[ai][bj][m][1];
                        if (sg) {
#pragma unroll
                            for (int j = 0; j < 4; ++j) { v0[j] = fmaxf(fast_sigmoid(v0[j]), 1e-30f); v1[j] = fmaxf(fast_sigmoid(v1[j]), 1e-30f); } }
                        u32x4 w; w.x = pk_bf16(v0[0], v0[1]); w.y = pk_bf16(v0[2], v0[3]); w.z = pk_bf16(v1[0], v1[1]); w.w = pk_bf16(v1[2], v1[3]);
                        *(u32x4*)(rowp + bj * 128) = w; } }
        } else if (mode == 1) {
#pragma unroll
            for (int ai = 0; ai < 2; ++ai) { u32x4 g[4][2];
#pragma unroll
                for (int m = 0; m < 4; ++m)
#pragma unroll
                    for (int bj = 0; bj < 2; ++bj) g[m][bj] = *(const u32x4*)(G + 4096 + (size_t)(row0 + ai * 128 + m * 16) * ldg + col0 + bj * 128);
#pragma unroll
                for (int m = 0; m < 4; ++m) { const size_t r = (size_t)(row0 + ai * 128 + m * 16);
#pragma unroll
                    for (int bj = 0; bj < 2; ++bj) { const f32x4 v0 = acc[ai][bj][m][0], v1 = acc[ai][bj][m][1]; const u32x4 gg = g[m][bj];
                        u32x4 w;
                        w.x = pk_bf16(bf_lo(gg.x) * v0[0], bf_hi(gg.x) * v0[1]); w.y = pk_bf16(bf_lo(gg.y) * v0[2], bf_hi(gg.y) * v0[3]);
                        w.z = pk_bf16(bf_lo(gg.z) * v1[0], bf_hi(gg.z) * v1[1]); w.w = pk_bf16(bf_lo(gg.w) * v1[2], bf_hi(gg.w) * v1[3]);
                        *(u32x4*)(O + r * ldc + col0 + bj * 128) = w; } } }
        } else {
#pragma unroll
            for (int ai = 0; ai < 2; ++ai) { f32x4 xv[4][2][2];
#pragma unroll
                for (int m = 0; m < 4; ++m)
#pragma unroll
                    for (int bj = 0; bj < 2; ++bj) { const size_t o = (size_t)(row0 + ai * 128 + m * 16) * ldc + col0 + bj * 128;
                        xv[m][bj][0] = *(const f32x4*)(X + o); xv[m][bj][1] = *(const f32x4*)(X + o + 4); }
#pragma unroll
                for (int m = 0; m < 4; ++m)
#pragma unroll
                    for (int bj = 0; bj < 2; ++bj) { const size_t o = (size_t)(row0 + ai * 128 + m * 16) * ldc + col0 + bj * 128;
                        *(f32x4*)(Of + o) = xv[m][bj][0] + acc[ai][bj][m][0]; *(f32x4*)(Of + o + 4) = xv[m][bj][1] + acc[ai][bj][m][1]; } }
        }
    }
};

__device__ __forceinline__ void cvt_tr_tile4(const float* __restrict__ src, u16* __restrict__ dst, int R, int C, int tile0, float* T, int ldd) {
    const int ntc = C >> 6, tid = threadIdx.x;
    f32x4 v[4][2];
#pragma unroll
    for (int q = 0; q < 4; ++q) { const int tile = tile0 + q, tr = tile / ntc, tc = tile - tr * ntc;
#pragma unroll
        for (int i = 0; i < 2; ++i) { const int idx = tid + i * NTHR, r = idx >> 4, c4 = idx & 15; v[q][i] = *(const f32x4*)(src + (size_t)(tr * 64 + r) * C + tc * 64 + c4 * 4); } }
#pragma unroll
    for (int q = 0; q < 4; ++q)
#pragma unroll
        for (int i = 0; i < 2; ++i) { const int idx = tid + i * NTHR, r = idx >> 4, c4 = idx & 15; float* t = T + q * 4160 + r * 65 + c4 * 4; t[0] = v[q][i][0]; t[1] = v[q][i][1]; t[2] = v[q][i][2]; t[3] = v[q][i][3]; }
    __syncthreads();
#pragma unroll
    for (int q = 0; q < 4; ++q) { const int tile = tile0 + q, tr = tile / ntc, tc = tile - tr * ntc; const int c = tid >> 3, r0 = (tid & 7) * 8; float x[8];
#pragma unroll
        for (int j = 0; j < 8; ++j) x[j] = T[q * 4160 + (r0 + j) * 65 + c];
        u32x4 w; w.x = pk_bf16(x[0], x[1]); w.y = pk_bf16(x[2], x[3]); w.z = pk_bf16(x[4], x[5]); w.w = pk_bf16(x[6], x[7]);
        *(u32x4*)(dst + (size_t)(tc * 64 + c) * ldd + tr * 64 + r0) = w; }
    __syncthreads();
}
template <int NR> __device__ __forceinline__ void rms_rows(const float* __restrict__ x, const float* __restrict__ g, u16* __restrict__ out, size_t rstride, int lane) {
    f32x4 v[NR][8]; float ss[NR];
#pragma unroll
    for (int q = 0; q < NR; ++q) { ss[q] = 0.f;
#pragma unroll
        for (int i = 0; i < 8; ++i) v[q][i] = ((const f32x4*)(x + q * rstride))[i * 64 + lane]; }
#pragma unroll
    for (int q = 0; q < NR; ++q) {
#pragma unroll
        for (int i = 0; i < 8; ++i) ss[q] += v[q][i][0] * v[q][i][0] + v[q][i][1] * v[q][i][1] + v[q][i][2] * v[q][i][2] + v[q][i][3] * v[q][i][3];
        ss[q] = rsqrtf(wave_sum(ss[q]) * (1.f / 2048.f) + EPS_); }
#pragma unroll
    for (int i = 0; i < 8; ++i) { const f32x4 gg = ((const f32x4*)g)[i * 64 + lane];
#pragma unroll
        for (int q = 0; q < NR; ++q) { const float rs = ss[q];
            u32x2 w; w.x = pk_bf16(v[q][i][0] * rs * gg[0], v[q][i][1] * rs * gg[1]); w.y = pk_bf16(v[q][i][2] * rs * gg[2], v[q][i][3] * rs * gg[3]);
            ((u32x2*)(out + q * rstride))[i * 64 + lane] = w; } }
}
__device__ __forceinline__ void sincos_d(double r, double& s, double& c) {
    const double r2 = r * r; double ts = 1.0, tc = 1.0;
    double ss = 0.0, cc = 0.0;
    double term_s = 1.0, term_c = 1.0; ss = 1.0; cc = 1.0;
#pragma unroll
    for (int k = 1; k <= 15; ++k) { term_c *= -r2 / (double)((2 * k - 1) * (2 * k)); term_s *= -r2 / (double)((2 * k) * (2 * k + 1)); cc += term_c; ss += term_s; }
    (void)ts; (void)tc;
    s = r * ss; c = cc;
}
__device__ __forceinline__ void phase_prep(const Params& p, unsigned char* lds) {
    float* T = (float*)lds;
    unsigned char* ws = p.ws;
    const int tid = threadIdx.x, lane = tid & 63, wave = tid >> 6;
    for (int j = blockIdx.x * 4; j < 4608 + 512; j += gridDim.x * 4) {
        if (j < 4608) cvt_tr_tile4(p.w_in, (u16*)(ws + WS_WIN_T), 2048, INW, j, T, 2048);
        else cvt_tr_tile4(p.w_mem_kv, (u16*)(ws + WS_WKV_T), 2048, 1024, j - 4608, T, 2048);
    }
    { const int nw = gridDim.x * 8, w0 = blockIdx.x * 8 + wave;
        for (int r = w0; r < S_; r += 4 * nw) {
            const size_t rst = (gridDim.x == 256) ? (size_t)256 * D_ : (size_t)nw * D_;
            if (r + 3 * nw < S_) rms_rows<4>(p.x + (size_t)ROWMAP(r) * D_, p.g_mix, (u16*)p.out + (size_t)ROWMAP(r) * D_, rst, lane);
            else for (int q = r; q < S_; q += nw) rms_rows<1>(p.x + (size_t)ROWMAP(q) * D_, p.g_mix, (u16*)p.out + (size_t)ROWMAP(q) * D_, 0, lane); }
        for (int r = w0; r < 256; r += nw) rms_rows<1>(p.mem + (size_t)r * D_, p.g_mem, (u16*)(ws + WS_MEMN) + (size_t)r * D_, 0, lane); }
}

#ifndef MIXDUP
#define MIXDUP 0
#endif
#ifndef MIX_MASK
#define MIX_MASK 7
#endif
struct SwaPre { u32x2 kra[3], krb[3]; f32x4 kcs[3], ksn[3]; u32x4 vr[3]; };
__device__ __forceinline__ void swa_preload(const Params& p, const int item, const int tid_in, SwaPre& R) {
    int zi = 0; asm volatile("" : "+v"(zi)); const int tid = tid_in + zi;
    const u16* __restrict__ proj = (const u16*)(p.ws + WS_PROJ);
    const float* __restrict__ COS = (const float*)(p.ws + WS_COS); const float* __restrict__ SIN = (const float*)(p.ws + WS_SIN);
    const int qt = item >> 2, kh = item & 3, t0 = qt * 64;
#pragma unroll
    for (int ps = 0; ps < 3; ++ps) { const int idx = ps * NTHR + tid, key = idx >> 3, l8 = idx & 7; int t = t0 - 128 + key; t = t < 0 ? 0 : t;
        const u16* kp = proj + (size_t)t * INW + C_K + kh * 64 + l8 * 4;
        R.kra[ps] = *(const u32x2*)kp; R.krb[ps] = *(const u32x2*)(kp + 32); R.kcs[ps] = *(const f32x4*)(COS + t * 32 + l8 * 4); R.ksn[ps] = *(const f32x4*)(SIN + t * 32 + l8 * 4);
        const int kb = idx >> 6, vkey = (kb >> 1) * 16 + (idx & 15), c8 = (kb & 1) * 4 + ((idx >> 4) & 3); int tv = t0 - 128 + vkey; tv = tv < 0 ? 0 : tv;
        R.vr[ps] = *(const u32x4*)(proj + (size_t)tv * INW + C_V + kh * 64 + c8 * 8); }
}
__device__ __forceinline__ void swa_item(const Params& p, int item, unsigned char* lds, float mbound_nat, const int tid_in, SwaPre& R, const int next_item) {
    int zi = 0; asm volatile("" : "+v"(zi)); const int tid = tid_in + zi;
    const u16* __restrict__ proj = (const u16*)(p.ws + WS_PROJ);
    const float* __restrict__ COS = (const float*)(p.ws + WS_COS); const float* __restrict__ SIN = (const float*)(p.ws + WS_SIN);
    u16* Ks = (u16*)lds;
    constexpr int VSTR = 200; u16* Vt = (u16*)(lds + 27648);
    const int qt = item >> 2, kh = item & 3, t0 = qt * 64;
    const int lane = tid & 63, wave = tid >> 6, fr = lane & 15, fq = lane >> 4;
    const f32x4 g1 = *(const f32x4*)(p.kg + (tid & 7) * 4), g2 = *(const f32x4*)(p.kg + 32 + (tid & 7) * 4);
#pragma unroll
    for (int ps = 0; ps < 3; ++ps) { const int idx = ps * NTHR + tid, key = idx >> 3, l8 = idx & 7, t = t0 - 128 + key;
        const bool ok = t >= 0; const u32x2 a = R.kra[ps], b = R.krb[ps];
        float x[8];
        x[0] = ok ? bf_lo(a.x) : 0.f; x[1] = ok ? bf_hi(a.x) : 0.f; x[2] = ok ? bf_lo(a.y) : 0.f; x[3] = ok ? bf_hi(a.y) : 0.f;
        x[4] = ok ? bf_lo(b.x) : 0.f; x[5] = ok ? bf_hi(b.x) : 0.f; x[6] = ok ? bf_lo(b.y) : 0.f; x[7] = ok ? bf_hi(b.y) : 0.f;
        const f32x4 cs = R.kcs[ps], sn = R.ksn[ps];
        float ss = 0.f;
#pragma unroll
        for (int j = 0; j < 8; ++j) ss += x[j] * x[j];
        ss = grp8_sum(ss);
        const float rs = rsqrtf(ss * (1.f / 64.f) + EPS_);
        float o1[4], o2[4];
#pragma unroll
        for (int j = 0; j < 4; ++j) { const float y1 = x[j] * rs * g1[j], y2 = x[4 + j] * rs * g2[j]; o1[j] = y1 * cs[j] - y2 * sn[j]; o2[j] = y2 * cs[j] + y1 * sn[j]; }
        u32x2 w1, w2; w1.x = pk_bf16(o1[0], o1[1]); w1.y = pk_bf16(o1[2], o1[3]); w2.x = pk_bf16(o2[0], o2[1]); w2.y = pk_bf16(o2[2], o2[3]);
        *(u32x2*)(Ks + key * 72 + l8 * 4) = w1; *(u32x2*)(Ks + key * 72 + 32 + l8 * 4) = w2; }
#pragma unroll
    for (int ps = 0; ps < 3; ++ps) { const int idx = ps * NTHR + tid, kb = idx >> 6, key = (kb >> 1) * 16 + (idx & 15), c8 = (kb & 1) * 4 + ((idx >> 4) & 3), t = t0 - 128 + key;
        u32x4 w = R.vr[ps]; if (t < 0) w = (u32x4){0u, 0u, 0u, 0u};
        u16* vp = Vt + (c8 * 8) * VSTR + key;
        vp[0] = (u16)w.x; vp[VSTR] = (u16)(w.x >> 16); vp[2 * VSTR] = (u16)w.y; vp[3 * VSTR] = (u16)(w.y >> 16);
        vp[4 * VSTR] = (u16)w.z; vp[5 * VSTR] = (u16)(w.z >> 16); vp[6 * VSTR] = (u16)w.w; vp[7 * VSTR] = (u16)(w.w >> 16); }
    __syncthreads();
    if (next_item >= 0) swa_preload(p, next_item, tid_in, R);
    {
        const int g = wave >> 1, half = wave & 1, head = kh * 4 + g, tw0 = t0 + half * 32;
        const float sinkv = p.sinks[head];
        const float mb = fmaxf(mbound_nat, sinkv) * LOG2E;
        const float qscale = 0.125f * LOG2E;
        bf16x8 qf[2][2];
#pragma unroll
        for (int mt = 0; mt < 2; ++mt) { const int t = tw0 + mt * 16 + fr;
            const u16* qp = proj + (size_t)t * INW + C_Q + head * 64 + fq * 8;
            const u32x4 a = *(const u32x4*)qp, b = *(const u32x4*)(qp + 32);
            float x1[8], x2[8];
            x1[0] = bf_lo(a.x); x1[1] = bf_hi(a.x); x1[2] = bf_lo(a.y); x1[3] = bf_hi(a.y); x1[4] = bf_lo(a.z); x1[5] = bf_hi(a.z); x1[6] = bf_lo(a.w); x1[7] = bf_hi(a.w);
            x2[0] = bf_lo(b.x); x2[1] = bf_hi(b.x); x2[2] = bf_lo(b.y); x2[3] = bf_hi(b.y); x2[4] = bf_lo(b.z); x2[5] = bf_hi(b.z); x2[6] = bf_lo(b.w); x2[7] = bf_hi(b.w);
            float ss = 0.f;
#pragma unroll
            for (int j = 0; j < 8; ++j) ss += x1[j] * x1[j] + x2[j] * x2[j];
            ss += shx(ss, lane, 16); ss += shx(ss, lane, 32);
            const float rs = rsqrtf(ss * (1.f / 64.f) + EPS_) * qscale;
            float o1[8], o2[8];
#pragma unroll
            for (int j = 0; j < 8; ++j) { const float c = COS[t * 32 + fq * 8 + j], s = SIN[t * 32 + fq * 8 + j];
                const float y1 = x1[j] * rs * p.qg[fq * 8 + j], y2 = x2[j] * rs * p.qg[32 + fq * 8 + j];
                o1[j] = y1 * c - y2 * s; o2[j] = y2 * c + y1 * s; }
            u32x4 w1, w2;
            w1.x = pk_bf16(o1[0], o1[1]); w1.y = pk_bf16(o1[2], o1[3]); w1.z = pk_bf16(o1[4], o1[5]); w1.w = pk_bf16(o1[6], o1[7]);
            w2.x = pk_bf16(o2[0], o2[1]); w2.y = pk_bf16(o2[2], o2[3]); w2.z = pk_bf16(o2[4], o2[5]); w2.w = pk_bf16(o2[6], o2[7]);
            qf[mt][0] = __builtin_bit_cast(bf16x8, w1); qf[mt][1] = __builtin_bit_cast(bf16x8, w2); }
        f32x4 sacc[10][2];
#pragma unroll
        for (int n = 0; n < 10; ++n) { sacc[n][0] = (f32x4){0.f, 0.f, 0.f, 0.f}; sacc[n][1] = (f32x4){0.f, 0.f, 0.f, 0.f}; }
#pragma unroll
        for (int n = 0; n < 10; ++n) { const int nt = 2 * half + n;
#pragma unroll
            for (int ks = 0; ks < 2; ++ks) { const bf16x8 kf = *(const bf16x8*)(Ks + (nt * 16 + fr) * 72 + ks * 32 + fq * 8);
                sacc[n][0] = mfma16(kf, qf[0][ks], sacc[n][0]); sacc[n][1] = mfma16(kf, qf[1][ks], sacc[n][1]); } }
        __builtin_amdgcn_sched_barrier(0);
        float lsum[2] = {0.f, 0.f};
        u32x2 pw[10][2];
#pragma unroll
        for (int n = 0; n < 10; ++n) { const int nt = 2 * half + n;
#pragma unroll
            for (int mt = 0; mt < 2; ++mt) { const int t = tw0 + mt * 16 + fr; float pv[4];
#pragma unroll
                for (int j = 0; j < 4; ++j) { const int s = t0 - 128 + nt * 16 + fq * 4 + j, df = t - s;
                    const bool ok = (df >= 0) && (df < 128) && (s >= 0);
                    pv[j] = ok ? __builtin_amdgcn_exp2f(sacc[n][mt][j] - mb) : 0.f; lsum[mt] += pv[j]; }
                pw[n][mt].x = pk_bf16(pv[0], pv[1]); pw[n][mt].y = pk_bf16(pv[2], pv[3]); } }
        f32x4 oacc[4][2];
#pragma unroll
        for (int d = 0; d < 4; ++d) { oacc[d][0] = (f32x4){0.f, 0.f, 0.f, 0.f}; oacc[d][1] = (f32x4){0.f, 0.f, 0.f, 0.f}; }
#pragma unroll
        for (int kk = 0; kk < 5; ++kk) { __builtin_amdgcn_sched_barrier(0); const int nta = 2 * half + 2 * kk;
            u32x4 b0, b1; b0.x = pw[2 * kk][0].x; b0.y = pw[2 * kk][0].y; b0.z = pw[2 * kk + 1][0].x; b0.w = pw[2 * kk + 1][0].y;
            b1.x = pw[2 * kk][1].x; b1.y = pw[2 * kk][1].y; b1.z = pw[2 * kk + 1][1].x; b1.w = pw[2 * kk + 1][1].y;
            const bf16x8 pf0 = __builtin_bit_cast(bf16x8, b0), pf1 = __builtin_bit_cast(bf16x8, b1);
#pragma unroll
            for (int d = 0; d < 4; ++d) { const u16* vp = Vt + (d * 16 + fr) * VSTR + nta * 16 + fq * 4;
                const u32x2 va = *(const u32x2*)vp, vb = *(const u32x2*)(vp + 16);
                u32x4 vv; vv.x = va.x; vv.y = va.y; vv.z = vb.x; vv.w = vb.y; const bf16x8 vf = __builtin_bit_cast(bf16x8, vv);
                oacc[d][0] = mfma16(vf, pf0, oacc[d][0]); oacc[d][1] = mfma16(vf, pf1, oacc[d][1]); } }
        const float sk = __builtin_amdgcn_exp2f(sinkv * LOG2E - mb);
        u16* BOA = (u16*)((unsigned char*)p.out + 67108864);
#pragma unroll
        for (int mt = 0; mt < 2; ++mt) { float l = lsum[mt]; l += shx(l, lane, 16); l += shx(l, lane, 32); l += sk;
            const float inv = 1.f / l; const int t = tw0 + mt * 16 + fr;
#pragma unroll
            for (int d = 0; d < 4; ++d) { u32x2 w; w.x = pk_bf16(oacc[d][mt][0] * inv, oacc[d][mt][1] * inv); w.y = pk_bf16(oacc[d][mt][2] * inv, oacc[d][mt][3] * inv);
                *(u32x2*)(BOA + (size_t)t * 2048 + head * 64 + d * 16 + fq * 4) = w; } }
    }
    __syncthreads();
}

__device__ __forceinline__ void mem_item(const Params& p, int item, unsigned char* lds, float mbound_nat, const int tid_in) {
    int zi = 0; asm volatile("" : "+v"(zi)); const int tid = tid_in + zi;
    const u16* __restrict__ proj = (const u16*)(p.ws + WS_PROJ);
    const u16* __restrict__ MKV = (const u16*)(p.ws + WS_MEMKV);
    u16* Ks = (u16*)lds;
    u16* Vt = (u16*)(lds + 69632);
    const int tt = item >> 2, h = item & 3, t0 = tt * 128;
    const int lane = tid & 63, wave = tid >> 6, fr = lane & 15, fq = lane >> 4;
#pragma unroll
    for (int ps = 0; ps < 8; ++ps) { const int idx = ps * NTHR + tid, key = idx >> 4, l16 = idx & 15;
        const u32x4 a = *(const u32x4*)(MKV + (size_t)key * 1024 + h * 128 + l16 * 8);
        float x[8]; x[0] = bf_lo(a.x); x[1] = bf_hi(a.x); x[2] = bf_lo(a.y); x[3] = bf_hi(a.y); x[4] = bf_lo(a.z); x[5] = bf_hi(a.z); x[6] = bf_lo(a.w); x[7] = bf_hi(a.w);
        float ss = 0.f;
#pragma unroll
        for (int j = 0; j < 8; ++j) ss += x[j] * x[j];
        ss = row_sum16(ss);
        const float rs = rsqrtf(ss * (1.f / 128.f) + EPS_);
        const f32x4 g1 = *(const f32x4*)(p.mkg + l16 * 8), g2 = *(const f32x4*)(p.mkg + l16 * 8 + 4);
        u32x4 w; w.x = pk_bf16(x[0] * rs * g1[0], x[1] * rs * g1[1]); w.y = pk_bf16(x[2] * rs * g1[2], x[3] * rs * g1[3]);
        w.z = pk_bf16(x[4] * rs * g2[0], x[5] * rs * g2[1]); w.w = pk_bf16(x[6] * rs * g2[2], x[7] * rs * g2[3]);
        *(u32x4*)(Ks + key * 136 + l16 * 8) = w;
        const int L = ps * NTHR + tid, kblk = L >> 6, vkey = (kblk & 15) * 16 + (L & 15), vc = (kblk >> 4) * 4 + ((L >> 4) & 3);
        const u32x4 v = *(const u32x4*)(MKV + (size_t)vkey * 1024 + 512 + h * 128 + vc * 8);
        u16* vp = Vt + (vc * 8) * 264 + vkey;
        vp[0] = (u16)v.x; vp[264] = (u16)(v.x >> 16); vp[528] = (u16)v.y; vp[792] = (u16)(v.y >> 16);
        vp[1056] = (u16)v.z; vp[1320] = (u16)(v.z >> 16); vp[1584] = (u16)v.w; vp[1848] = (u16)(v.w >> 16); }
    __syncthreads();
    {
        const float mb = mbound_nat * LOG2E;
        const float qscale = 0.08838834764831845f * LOG2E;
        const int t = t0 + wave * 16 + fr;
        bf16x8 qf[4];
        { u32x4 a[4]; float ss = 0.f;
#pragma unroll
            for (int ks = 0; ks < 4; ++ks) { a[ks] = *(const u32x4*)(proj + (size_t)t * INW + C_MQ + h * 128 + ks * 32 + fq * 8);
                const float x0 = bf_lo(a[ks].x), x1 = bf_hi(a[ks].x), x2 = bf_lo(a[ks].y), x3 = bf_hi(a[ks].y), x4 = bf_lo(a[ks].z), x5 = bf_hi(a[ks].z), x6 = bf_lo(a[ks].w), x7 = bf_hi(a[ks].w);
                ss += x0 * x0 + x1 * x1 + x2 * x2 + x3 * x3 + x4 * x4 + x5 * x5 + x6 * x6 + x7 * x7; }
            ss += shx(ss, lane, 16); ss += shx(ss, lane, 32);
            const float rs = rsqrtf(ss * (1.f / 128.f) + EPS_) * qscale;
#pragma unroll
            for (int ks = 0; ks < 4; ++ks) { const float* gp = p.mqg + ks * 32 + fq * 8; u32x4 w;
                w.x = pk_bf16(bf_lo(a[ks].x) * rs * gp[0], bf_hi(a[ks].x) * rs * gp[1]); w.y = pk_bf16(bf_lo(a[ks].y) * rs * gp[2], bf_hi(a[ks].y) * rs * gp[3]);
                w.z = pk_bf16(bf_lo(a[ks].z) * rs * gp[4], bf_hi(a[ks].z) * rs * gp[5]); w.w = pk_bf16(bf_lo(a[ks].w) * rs * gp[6], bf_hi(a[ks].w) * rs * gp[7]);
                qf[ks] = __builtin_bit_cast(bf16x8, w); } }
        f32x4 sacc[16];
#pragma unroll
        for (int n = 0; n < 16; ++n) sacc[n] = (f32x4){0.f, 0.f, 0.f, 0.f};
#pragma unroll
        for (int n = 0; n < 16; ++n)
#pragma unroll
            for (int ks = 0; ks < 4; ++ks) { const bf16x8 kf = *(const bf16x8*)(Ks + (n * 16 + fr) * 136 + ks * 32 + fq * 8); sacc[n] = mfma16(kf, qf[ks], sacc[n]); }
        __builtin_amdgcn_sched_barrier(0);
        float lsum = 0.f; u32x2 pw[16];
#pragma unroll
        for (int n = 0; n < 16; ++n) { float pv[4];
#pragma unroll
            for (int j = 0; j < 4; ++j) { pv[j] = __builtin_amdgcn_exp2f(sacc[n][j] - mb); lsum += pv[j]; }
            pw[n].x = pk_bf16(pv[0], pv[1]); pw[n].y = pk_bf16(pv[2], pv[3]); }
        f32x4 oacc[8];
#pragma unroll
        for (int d = 0; d < 8; ++d) oacc[d] = (f32x4){0.f, 0.f, 0.f, 0.f};
#pragma unroll
        for (int kk = 0; kk < 8; ++kk) { __builtin_amdgcn_sched_barrier(0); u32x4 b; b.x = pw[2 * kk].x; b.y = pw[2 * kk].y; b.z = pw[2 * kk + 1].x; b.w = pw[2 * kk + 1].y;
            const bf16x8 pf = __builtin_bit_cast(bf16x8, b);
#pragma unroll
            for (int d = 0; d < 8; ++d) { const u16* vp = Vt + (d * 16 + fr) * 264 + kk * 32 + fq * 4;
                const u32x2 va = *(const u32x2*)vp, vb = *(const u32x2*)(vp + 16);
                u32x4 vv; vv.x = va.x; vv.y = va.y; vv.z = vb.x; vv.w = vb.y;
                oacc[d] = mfma16(__builtin_bit_cast(bf16x8, vv), pf, oacc[d]); } }
        lsum += shx(lsum, lane, 16); lsum += shx(lsum, lane, 32);
        const float inv = 1.f / lsum;
        u16* BOM = (u16*)((unsigned char*)p.out + 67108864) + 1536;
#pragma unroll
        for (int d = 0; d < 8; ++d) { u32x2 w; w.x = pk_bf16(oacc[d][0] * inv, oacc[d][1] * inv); w.y = pk_bf16(oacc[d][2] * inv, oacc[d][3] * inv);
            *(u32x2*)(BOM + (size_t)t * 2048 + h * 128 + d * 16 + fq * 4) = w; }
    }
    __syncthreads();
}

__device__ __forceinline__ void conv_item(const Params& p, int item, unsigned char* lds, const int tid_in) {
    int zi = 0; asm volatile("" : "+v"(zi)); const int tid = tid_in + zi;
    const u16* __restrict__ proj = (const u16*)(p.ws + WS_PROJ);
    float* G = (float*)lds;
    float* red = (float*)(lds + 126976);
    const int lane = tid & 63, wave = tid >> 6;
    const int t0 = item * 32;
    { const int c8 = (tid & 63) * 8, rr = tid >> 6;
        u32x4 av[8], bv[8];
#pragma unroll
        for (int ps = 0; ps < 8; ++ps) { const int r = ps * 8 + rr; int t = t0 - 30 + r; t = t < 0 ? 0 : (t > S_ - 1 ? S_ - 1 : t);
            av[ps] = *(const u32x4*)(proj + (size_t)t * INW + C_CA + c8); bv[ps] = *(const u32x4*)(proj + (size_t)t * INW + C_CB + c8); }
#pragma unroll
        for (int ps = 0; ps < 8; ++ps) { const int r = ps * 8 + rr, t = t0 - 30 + r;
            if (r < 62) { const bool ok = t >= 0; f32x4 g0, g1;
                g0[0] = ok ? bf_lo(av[ps].x) * fast_sigmoid(bf_lo(bv[ps].x)) : 0.f; g0[1] = ok ? bf_hi(av[ps].x) * fast_sigmoid(bf_hi(bv[ps].x)) : 0.f;
                g0[2] = ok ? bf_lo(av[ps].y) * fast_sigmoid(bf_lo(bv[ps].y)) : 0.f; g0[3] = ok ? bf_hi(av[ps].y) * fast_sigmoid(bf_hi(bv[ps].y)) : 0.f;
                g1[0] = ok ? bf_lo(av[ps].z) * fast_sigmoid(bf_lo(bv[ps].z)) : 0.f; g1[1] = ok ? bf_hi(av[ps].z) * fast_sigmoid(bf_hi(bv[ps].z)) : 0.f;
                g1[2] = ok ? bf_lo(av[ps].w) * fast_sigmoid(bf_lo(bv[ps].w)) : 0.f; g1[3] = ok ? bf_hi(av[ps].w) * fast_sigmoid(bf_hi(bv[ps].w)) : 0.f;
                *(f32x4*)(G + r * 512 + c8) = g0; *(f32x4*)(G + r * 512 + c8 + 4) = g1; } } }
    __syncthreads();
    const int ch = tid;
    const float bias = p.dw_b[ch];
    float wgt[31];
#pragma unroll
    for (int j = 0; j < 31; ++j) wgt[j] = p.dw_w[j * 512 + ch];
#pragma unroll 1
    for (int sub = 0; sub < 4; ++sub) { const int base = sub * 8;
        float g[38];
#pragma unroll
        for (int r = 0; r < 38; ++r) g[r] = G[(base + r) * 512 + ch];
        float ac[8];
#pragma unroll
        for (int o = 0; o < 8; ++o) ac[o] = bias;
#pragma unroll
        for (int j = 0; j < 31; ++j) {
#pragma unroll
            for (int o = 0; o < 8; ++o) ac[o] += wgt[j] * g[o + j]; }
#pragma unroll
        for (int o = 0; o < 8; ++o) { G[(base + o) * 512 + ch] = ac[o];
            const float s = wave_sum(ac[o]), q = wave_sum(ac[o] * ac[o]);
            if (lane == 0) { red[wave * 64 + base + o] = s; red[wave * 64 + 32 + base + o] = q; } } }
    __syncthreads();
    if (tid < 64) { float t = 0.f;
#pragma unroll
        for (int w = 0; w < 8; ++w) t += red[w * 64 + tid];
        red[512 + tid] = t; }
    __syncthreads();
    const float lg = p.ln_g[ch], lb = p.ln_b[ch];
    u16* BOC = (u16*)((unsigned char*)p.out + 67108864) + 1024;
#pragma unroll
    for (int k = 0; k < 32; ++k) { const float s = red[512 + k], q = red[512 + 32 + k];
        const float mu = s * (1.f / 512.f), var = fmaxf(q * (1.f / 512.f) - mu * mu, 0.f), rstd = rsqrtf(var + EPS_);
        const float y = (G[k * 512 + ch] - mu) * rstd * lg + lb;
        const u32 w = pk_bf16(y * fast_sigmoid(y), 0.f);
        BOC[(size_t)(t0 + k) * 2048 + ch] = (u16)w; }
    __syncthreads();
}

__device__ __forceinline__ void phase_mix(const Params& p, unsigned char* lds) {
    float mq = 0.f, mk = 0.f, mmq = 0.f, mmk = 0.f;
    for (int i = 0; i < 64; ++i) { mq = fmaxf(mq, fabsf(p.qg[i])); mk = fmaxf(mk, fabsf(p.kg[i])); }
    for (int i = 0; i < 128; ++i) { mmq = fmaxf(mmq, fabsf(p.mqg[i])); mmk = fmaxf(mmk, fabsf(p.mkg[i])); }
    const float swa_bound = 8.f * mq * mk * 1.02f + 0.1f, mem_bound = 11.313708498984761f * mmq * mmk * 1.02f + 0.1f;
    if (MIX_MASK & 1) { int z = 0; asm volatile("" : "+v"(z)); const int tz = threadIdx.x + z;
#define SWA_ITEM(v) (((((v) & 7) * 32 + (((v) >> 3) & 31)) << 2) | ((v) >> 8))
        SwaPre pre; if ((int)blockIdx.x < 1024) swa_preload(p, SWA_ITEM((int)blockIdx.x), tz, pre);
        for (int it = blockIdx.x; it < 1024; it += gridDim.x) { const int nx = it + (int)gridDim.x; swa_item(p, SWA_ITEM(it), lds, swa_bound, tz, pre, nx < 1024 ? SWA_ITEM(nx) : -1); } }
    if (MIX_MASK & 2) { int z = 0; asm volatile("" : "+v"(z)); const int tz = threadIdx.x + z; for (int it = blockIdx.x; it < 512; it += gridDim.x) mem_item(p, ((((it & 7) * 16 + (it >> 5)) << 2) | ((it >> 3) & 3)), lds, mem_bound, tz); }
    if (MIX_MASK & 4) { int z = 0; asm volatile("" : "+v"(z)); const int tz = threadIdx.x + z; for (int rep = 0; rep < ((MIXDUP & 4) ? 2 : 1); ++rep) for (int it = blockIdx.x; it < 512; it += gridDim.x) conv_item(p, ((it & 7) << 6) | (it >> 3), lds, tz); }
}

__device__ __forceinline__ void phase_h2(const Params& p) {
    const int tid = threadIdx.x, lane = tid & 63, wave = tid >> 6;
    { const int nw = gridDim.x * 8, w0 = blockIdx.x * 8 + wave;
        for (int r = w0; r < S_; r += 4 * nw) {
            const size_t rst = (gridDim.x == 256) ? (size_t)256 * D_ : (size_t)nw * D_;
            if (r + 3 * nw < S_) rms_rows<4>(p.out + (size_t)ROWMAP(r) * D_, p.g_ffn, (u16*)(p.ws + WS_MERGED) + (size_t)ROWMAP(r) * D_, rst, lane);
            else for (int q = r; q < S_; q += nw) rms_rows<1>(p.out + (size_t)ROWMAP(q) * D_, p.g_ffn, (u16*)(p.ws + WS_MERGED) + (size_t)ROWMAP(q) * D_, 0, lane); } }
}

__device__ __forceinline__ void convert_experts(const Params& p, const int part) {
    int zc = 0; asm volatile("" : "+v"(zc)); const int tid = (int)threadIdx.x + zc, lane = tid & 63, wave = tid >> 6;
    for (int rr = part * 8192 + blockIdx.x * 8 + wave; rr < (part + 1) * 8192; rr += gridDim.x * 8) {
        f32x4 v[2][8]; float mx[2] = {0.f, 0.f};
#pragma unroll
        for (int q = 0; q < 2; ++q) { const float* src = (q ? p.ev : p.eu) + (size_t)rr * 2048 + lane * 32;
#pragma unroll
            for (int k = 0; k < 8; ++k) v[q][k] = *(const f32x4*)(src + k * 4); }
#pragma unroll
        for (int q = 0; q < 2; ++q) {
#pragma unroll
            for (int k = 0; k < 8; ++k) mx[q] = fmaxf(mx[q], fmaxf(fmaxf(fabsf(v[q][k][0]), fabsf(v[q][k][1])), fmaxf(fabsf(v[q][k][2]), fabsf(v[q][k][3]))));
            mx[q] = wave_max(mx[q]);
            const u32 mb = __float_as_uint(mx[q]); int eb = (int)((mb >> 23) & 255u); eb = eb < 8 ? 8 : (eb > 250 ? 250 : eb);
            const bool small = (mb & 0x7fffffu) <= 0x700000u;
            const float sc = __uint_as_float((u32)((small ? 256 : 255) - eb) << 23), inv = __uint_as_float((u32)(eb - (small ? 2 : 1)) << 23);
            v16f xa, xb;
#pragma unroll
            for (int i = 0; i < 16; ++i) { xa[i] = v[q][(2 * i) >> 2][(2 * i) & 3] * sc; xb[i] = v[q][(2 * i + 1) >> 2][(2 * i + 1) & 3] * sc; }
            const v6u qq = __builtin_amdgcn_cvt_scalef32_2xpk16_fp6_f32(xa, xb, 1.0f);
            unsigned char* dst = p.ws + WS_EU + (size_t)rr * 3072 + (q ? 1536 : 0);
            *(u32x4*)(dst + lane * 16) = (u32x4){qq[0], qq[1], qq[2], qq[3]};
            *(u32x2*)(dst + 1024 + lane * 8) = (u32x2){qq[4], qq[5]};
            if (lane == 0) ((float*)(p.ws + (q ? WS_SVI : WS_SUI)))[rr] = inv; } }
}

constexpr unsigned char CAND_I[64] = {0,0,0,0,0,0,0,0,0,0,0,0,0,0,0,0,1,1,1,1,1,1,1,1,2,2,2,2,2,3,3,3,3,4,4,4,5,5,6,6,7,7,8,9,10,11,12,13,14,15,255,255,255,255,255,255,255,255,255,255,255,255,255,255};
constexpr unsigned char CAND_J[64] = {0,1,2,3,4,5,6,7,8,9,10,11,12,13,14,15,0,1,2,3,4,5,6,7,0,1,2,3,4,0,1,2,3,0,1,2,0,1,0,1,0,1,0,0,0,0,0,0,0,0,255,255,255,255,255,255,255,255,255,255,255,255,255,255};
__device__ __forceinline__ void sort16_desc(u32 (&a)[16]) {
#pragma unroll
    for (int k = 2; k <= 16; k <<= 1)
#pragma unroll
        for (int j = k >> 1; j > 0; j >>= 1)
#pragma unroll
            for (int i = 0; i < 16; ++i) { const int l = i ^ j;
                if (l > i) { const bool desc = ((i & k) == 0); const u32 hi = max(a[i], a[l]), lo = min(a[i], a[l]); a[i] = desc ? hi : lo; a[l] = desc ? lo : hi; } }
}
__device__ __forceinline__ void merge16_desc(u32 (&R)[16], const u32 (&G)[16]) {
#pragma unroll
    for (int i = 0; i < 16; ++i) R[i] = max(R[i], G[15 - i]);
#pragma unroll
    for (int j = 8; j > 0; j >>= 1)
#pragma unroll
        for (int i = 0; i < 16; ++i) { const int l = i ^ j; if (l > i) { const u32 hi = max(R[i], R[l]), lo = min(R[i], R[l]); R[i] = hi; R[l] = lo; } }
}
__device__ __forceinline__ void topk_rows(const Params& p, unsigned char* lds, const int tok0, const int lgn, const int hbase, const int tid_in) {
    int zi = 0; asm volatile("" : "+v"(zi)); const int tid = tid_in + zi;
    float* sc = (float*)lds;
    float* tv = (float*)lds;
    int* ti = (int*)(lds + 17408);
    const u16* __restrict__ Q = (const u16*)(p.ws + WS_Q); const u16* __restrict__ SK = (const u16*)(p.ws + WS_SK);
    const int nmask = (1 << lgn) - 1;
    const int lane = tid & 63, wave = tid >> 6, fr = lane & 15, fq = lane >> 4;
    {
        const int side = wave & 1, quarter = wave >> 1;
        bf16x8 af[2][4]; int hd[2];
#pragma unroll
        for (int mt = 0; mt < 2; ++mt) { const int rho0 = quarter * 32 + mt * 16; hd[mt] = hbase + (rho0 >> lgn);
#pragma unroll
            for (int ks = 0; ks < 4; ++ks) af[mt][ks] = *(const bf16x8*)(Q + (size_t)(tok0 + ((rho0 + fr) & nmask)) * 2048 + hd[mt] * 256 + side * 128 + ks * 32 + fq * 8); }
        f32x4 acc[2][8];
#pragma unroll
        for (int nt = 0; nt < 8; ++nt) { acc[0][nt] = (f32x4){0.f, 0.f, 0.f, 0.f}; acc[1][nt] = (f32x4){0.f, 0.f, 0.f, 0.f}; }
#pragma unroll
        for (int mt = 0; mt < 2; ++mt)
#pragma unroll
            for (int nt = 0; nt < 8; ++nt)
#pragma unroll
                for (int ks = 0; ks < 4; ++ks) { const bf16x8 b = *(const bf16x8*)(SK + (size_t)((hd[mt] * 2 + side) * 128 + nt * 16 + fr) * 128 + ks * 32 + fq * 8);
                    acc[mt][nt] = mfma16(af[mt][ks], b, acc[mt][nt]); }
#pragma unroll
        for (int mt = 0; mt < 2; ++mt)
#pragma unroll
            for (int nt = 0; nt < 8; ++nt)
#pragma unroll
                for (int j = 0; j < 4; ++j) sc[(side * 128 + quarter * 32 + mt * 16 + fq * 4 + j) * 129 + nt * 16 + fr] = acc[mt][nt][j];
    }
    __syncthreads();
    u32 v[16]; float val[16]; const int tok = tid & 127, sd = (tid >> 7) & 1, half = tid >> 8;
    u32* kbuf = (u32*)(lds + 132096);
    const float* row = sc + (sd * 128 + tok) * 129;
#pragma unroll
    for (int k = 0; k < 16; ++k) { v[k] = 0u; val[k] = 0.f; }
#pragma unroll
    for (int grp = 0; grp < 4; ++grp) { u32 gk[16];
#pragma unroll
        for (int i = 0; i < 16; ++i) { const int n = half * 64 + grp * 16 + i; gk[i] = (mono_key(row[n]) & ~127u) | (u32)(127 - n); }
        sort16_desc(gk);
        if (grp == 0) {
#pragma unroll
            for (int i = 0; i < 16; ++i) v[i] = gk[i]; }
        else merge16_desc(v, gk); }
    if (half) {
#pragma unroll
        for (int k = 0; k < 16; ++k) kbuf[(sd * 128 + tok) * 17 + k] = v[k]; }
    __syncthreads();
    if (!half) { u32 gk[16];
#pragma unroll
        for (int i = 0; i < 16; ++i) gk[i] = kbuf[(sd * 128 + tok) * 17 + i];
        merge16_desc(v, gk);
#pragma unroll
        for (int k = 0; k < 16; ++k) val[k] = row[127 - (int)(v[k] & 127u)]; }
    __syncthreads();
    if (!half) {
#pragma unroll
        for (int k = 0; k < 16; ++k) { tv[(sd * 128 + tok) * 17 + k] = val[k]; ti[(sd * 128 + tok) * 17 + k] = 127 - (int)(v[k] & 127u); } }
    __syncthreads();
    if (tid < 128) { float v1[16], v2[16];
#pragma unroll
        for (int k = 0; k < 16; ++k) { v1[k] = tv[tid * 17 + k]; v2[k] = tv[(128 + tid) * 17 + k]; }
        u32 w[16];
#pragma unroll
        for (int grp = 0; grp < 4; ++grp) { u32 gk[16];
#pragma unroll
            for (int i = 0; i < 16; ++i) { const int c = grp * 16 + i;
                gk[i] = (CAND_I[c] < 16) ? ((mono_key(v1[CAND_I[c] & 15] + v2[CAND_J[c] & 15]) & ~255u) | (u32)(255 - ((CAND_I[c] & 15) * 16 + (CAND_J[c] & 15)))) : 0u; }
            sort16_desc(gk);
            if (grp == 0) {
#pragma unroll
                for (int i = 0; i < 16; ++i) w[i] = gk[i]; }
            else merge16_desc(w, gk); }
        float s[16]; int eid[16]; float m = -3.0e38f;
#pragma unroll
        for (int k = 0; k < 16; ++k) { const int cid = 255 - (int)(w[k] & 255u), i = cid >> 4, j = cid & 15;
            s[k] = tv[tid * 17 + i] + tv[(128 + tid) * 17 + j]; eid[k] = ti[tid * 17 + i] * 128 + ti[(128 + tid) * 17 + j]; m = fmaxf(m, s[k]); }
        float sum = 0.f;
#pragma unroll
        for (int k = 0; k < 16; ++k) { s[k] = __expf(s[k] - m); sum += s[k]; }
        const float inv = 1.f / sum;
        const size_t so = (size_t)(tok0 + (tid & nmask)) * 128 + (hbase + (tid >> lgn)) * 16;
        int* SI = (int*)(p.ws + WS_SI) + so; float* SG = (float*)(p.ws + WS_SG) + so;
        float* SGU = (float*)(p.ws + WS_SGU) + so; const float* SUI = (const float*)(p.ws + WS_SUI); const float* SVI = (const float*)(p.ws + WS_SVI);
        float svi[16], sui[16];
#pragma unroll
        for (int k = 0; k < 16; ++k) { svi[k] = SVI[eid[k]]; sui[k] = SUI[eid[k]]; }
#pragma unroll
        for (int k = 0; k < 16; k += 4) { *(int4*)(SI + k) = make_int4(eid[k], eid[k + 1], eid[k + 2], eid[k + 3]);
            *(f32x4*)(SG + k) = (f32x4){s[k] * inv * svi[k], s[k + 1] * inv * svi[k + 1], s[k + 2] * inv * svi[k + 2], s[k + 3] * inv * svi[k + 3]};
            *(f32x4*)(SGU + k) = (f32x4){sui[k], sui[k + 1], sui[k + 2], sui[k + 3]}; } }
    __syncthreads();
}

__device__ __forceinline__ void peer_token(const Params& p, const int tok, const int lane) {
    const u16* __restrict__ H2 = (const u16*)(p.ws + WS_MERGED);
    const unsigned char* __restrict__ EU = p.ws + WS_EU; const unsigned char* __restrict__ EV = p.ws + WS_EV;
    const int* __restrict__ SI = (const int*)(p.ws + WS_SI); const float* __restrict__ SG = (const float*)(p.ws + WS_SG); const float* __restrict__ SGU = (const float*)(p.ws + WS_SGU);
    {
        f32x2 h[16];
#pragma unroll
        for (int c = 0; c < 4; ++c) { const u32x4 a = *(const u32x4*)(H2 + (size_t)tok * 2048 + lane * 32 + c * 8);
            h[c * 4 + 0] = (f32x2){bf_lo(a.x), bf_hi(a.x)}; h[c * 4 + 1] = (f32x2){bf_lo(a.y), bf_hi(a.y)}; h[c * 4 + 2] = (f32x2){bf_lo(a.z), bf_hi(a.z)}; h[c * 4 + 3] = (f32x2){bf_lo(a.w), bf_hi(a.w)}; }
        const int i0 = SI[(size_t)tok * 128 + lane], i1 = SI[(size_t)tok * 128 + 64 + lane];
        const float g0 = SG[(size_t)tok * 128 + lane], g1 = SG[(size_t)tok * 128 + 64 + lane];
        const float r0 = SGU[(size_t)tok * 128 + lane], r1 = SGU[(size_t)tok * 128 + 64 + lane];
        f32x2 y[16];
#pragma unroll
        for (int k = 0; k < 16; ++k) y[k] = (f32x2){0.f, 0.f};
        u32x4 uA, vA, uB, vB, uC, vC, uD, vD, uE, vE, uF, vF; u32x2 uA2, vA2, uB2, vB2, uC2, vC2, uD2, vD2, uE2, vE2, uF2, vF2;
#define PEER_LOAD(e, U, V) do { const int _e = (e); const int _id = __builtin_amdgcn_readlane(_e < 64 ? i0 : i1, _e & 63); \
            const unsigned char* _pu = EU + (size_t)_id * 3072; const unsigned char* _pv = _pu + 1536; \
            U = *(const u32x4*)(_pu + lane * 16); U##2 = *(const u32x2*)(_pu + 1024 + lane * 8); V = *(const u32x4*)(_pv + lane * 16); V##2 = *(const u32x2*)(_pv + 1024 + lane * 8); } while (0)
#define PEER_COMP(e, U, V) do { const int _e = (e); f32x2 a0 = (f32x2){0.f, 0.f}, a1 = (f32x2){0.f, 0.f}; \
            { const v32f uf = __builtin_amdgcn_cvt_scalef32_pk32_f32_fp6((v6u){U.x, U.y, U.z, U.w, (U##2).x, (U##2).y}, 1.0f); \
            _Pragma("unroll") for (int k = 0; k < 16; k += 2) { a0 = __builtin_elementwise_fma((f32x2){uf[2 * k], uf[2 * k + 1]}, h[k], a0); a1 = __builtin_elementwise_fma((f32x2){uf[2 * k + 2], uf[2 * k + 3]}, h[k + 1], a1); } } \
            const float a = wave_sum((a0.x + a0.y) + (a1.x + a1.y)) * rdlane(_e < 64 ? r0 : r1, _e & 63); const float gt_ = rdlane(_e < 64 ? g0 : g1, _e & 63); \
            const float act = 0.5f * a * (1.f + erff(a * 0.70710678118654752f)) * gt_; const f32x2 act2 = (f32x2){act, act}; \
            { const v32f vf = __builtin_amdgcn_cvt_scalef32_pk32_f32_fp6((v6u){V.x, V.y, V.z, V.w, (V##2).x, (V##2).y}, 1.0f); \
            _Pragma("unroll") for (int k = 0; k < 16; ++k) y[k] = __builtin_elementwise_fma((f32x2){vf[2 * k], vf[2 * k + 1]}, act2, y[k]); } } while (0)
        PEER_LOAD(0, uA, vA); PEER_LOAD(1, uB, vB); PEER_LOAD(2, uC, vC); PEER_LOAD(3, uD, vD); PEER_LOAD(4, uE, vE);
        for (int e = 0; e < 126; e += 6) {
            PEER_LOAD(e + 5, uF, vF);
            PEER_COMP(e, uA, vA);
            PEER_LOAD(e + 6, uA, vA);
            PEER_COMP(e + 1, uB, vB);
            PEER_LOAD(e + 7, uB, vB);
            PEER_COMP(e + 2, uC, vC);
            if (e + 8 < 128) PEER_LOAD(e + 8, uC, vC);
            PEER_COMP(e + 3, uD, vD);
            if (e + 8 < 128) PEER_LOAD(e + 9, uD, vD);
            PEER_COMP(e + 4, uE, vE);
            if (e + 8 < 128) PEER_LOAD(e + 10, uE, vE);
            PEER_COMP(e + 5, uF, vF);
        }
        PEER_COMP(126, uA, vA); PEER_COMP(127, uB, vB);
#undef PEER_LOAD
#undef PEER_COMP
        float* op = p.out + (size_t)tok * 2048 + lane * 32; f32x4 xo[8];
#pragma unroll
        for (int k = 0; k < 8; ++k) xo[k] = *(const f32x4*)(op + k * 4);
#pragma unroll
        for (int k = 0; k < 8; ++k) { f32x4 a = xo[k];
            a[0] += y[2 * k].x; a[1] += y[2 * k].y; a[2] += y[2 * k + 1].x; a[3] += y[2 * k + 1].y;
            *(f32x4*)(op + k * 4) = a; }
    }
}


__device__ __forceinline__ void phase_topk_peer(const Params& p, unsigned char* lds) {
    for (int tbv = blockIdx.x; tbv < S_ / 64; tbv += gridDim.x) {
        const int tb = (gridDim.x == 256) ? (((tbv & 7) << 5) | (tbv >> 3)) : tbv;
        const int pat = ((blockIdx.x >> 3) & 1) ? 1 : 2;
        const int code = pat == 1 ? 0x4310 : 0x420, nb = (pat & 1) ? 3 : 2;
#pragma unroll 1
        for (int bi = 0; bi < nb; ++bi) {
            const int u0 = (code >> (4 * bi)) & 15, u1 = (code >> (4 * bi + 4)) & 15, t0 = tb * 64 + u0 * 16, ntok = (u1 - u0) * 16;
#pragma unroll 1
            for (int u = u0; u < u1; ++u) topk_rows(p, lds, tb * 64 + u * 16, 4, 0, (int)threadIdx.x);
            __syncthreads();
            { int z = 0; asm volatile("" : "+v"(z)); const int tz = (int)threadIdx.x + z; const int lane = tz & 63, wave = __builtin_amdgcn_readfirstlane(tz >> 6), per = ntok >> 3;
#pragma unroll 1
                for (int i = 0; i < per; ++i) peer_token(p, t0 + wave * per + i, lane); }
        }
    }
}

constexpr int N_PHASES = 8;
#ifndef DUPMASK
#define DUPMASK 0
#endif
#ifndef PH_MASK
#define PH_MASK 0x1ff
#endif

__device__ __forceinline__ void late_transposes(const Params& p, unsigned char* lds) {
    float* T = (float*)lds; unsigned char* ws = p.ws;
    for (int j = blockIdx.x * 4; j < 3072; j += gridDim.x * 4) {
        if (j < 512) cvt_tr_tile4(p.w_attn_o, (u16*)(ws + WS_WA_T), 1024, 2048, j, T, 2048);
        else if (j < 768) cvt_tr_tile4(p.w_conv_o, (u16*)(ws + WS_WA_T) + 1024, 512, 2048, j - 512, T, 2048);
        else if (j < 1024) cvt_tr_tile4(p.w_mem_o, (u16*)(ws + WS_WA_T) + 1536, 512, 2048, j - 768, T, 2048);
        else if (j < 2048) cvt_tr_tile4(p.w_out, (u16*)(ws + WS_WOUT_T), 2048, 2048, j - 1024, T, 2048);
        else cvt_tr_tile4(p.w_query, (u16*)(ws + WS_WQ_T), 2048, 2048, j - 2048, T, 2048);
    }
    const int tid = threadIdx.x;
    const int gt = blockIdx.x * NTHR + tid, gn = gridDim.x * NTHR;
    for (int i = gt; i < S_ * 32; i += gn) { const int t = i >> 5, j = i & 31;
        const double invf = exp2(-(double)j * (13.287712379549449 / 32.0));
        const double ang = (double)p.pos[t] * invf;
        const double n = rint(ang * 0.15915494309189535);
        double r = fma(-n, 6.283185307179586, ang); r = fma(-n, 2.4492935982947064e-16, r);
        double s, c; sincos_d(r, s, c);
        ((float*)(ws + WS_COS))[i] = (float)c; ((float*)(ws + WS_SIN))[i] = (float)s; }
    for (int i = gt; i < 16 * 128 * 128 / 4; i += gn) { const f32x4 v = ((const f32x4*)p.sub_keys)[i]; u32x2 w; w.x = pk_bf16(v[0], v[1]); w.y = pk_bf16(v[2], v[3]); ((u32x2*)(ws + WS_SK))[i] = w; }
}

__device__ __forceinline__ void memkv_direct(const Params& p, unsigned char* lds) {
    const u16* __restrict__ A = (const u16*)(p.ws + WS_MEMN); const u16* __restrict__ B = (const u16*)(p.ws + WS_WKV_T);
    u16* O = (u16*)(p.ws + WS_MEMKV);
    float* red = (float*)lds;
    int z = 0; asm volatile("" : "+v"(z));
    const int tid = threadIdx.x + z, lane = tid & 63, wave = tid >> 6, fr = lane & 15, fq = lane >> 4, tw = wave & 3, kh = wave >> 2;
    for (int base = blockIdx.x * 4; base < 1024; base += gridDim.x * 4) {
        const int tile = base + tw, mt = tile & 15, nt = tile >> 4;
        const u16* ap = A + (size_t)(mt * 16 + fr) * 2048 + kh * 1024 + fq * 8; const u16* bp = B + (size_t)(nt * 16 + fr) * 2048 + kh * 1024 + fq * 8;
        f32x4 acc = (f32x4){0.f, 0.f, 0.f, 0.f};
#pragma unroll 8
        for (int ks = 0; ks < 32; ++ks) acc = mfma16(*(const bf16x8*)(ap + ks * 32), *(const bf16x8*)(bp + ks * 32), acc);
        if (kh) *(f32x4*)(red + (tw * 64 + lane) * 4) = acc;
        __syncthreads();
        if (!kh) { const f32x4 o = acc + *(const f32x4*)(red + (tw * 64 + lane) * 4);
#pragma unroll
            for (int j = 0; j < 4; ++j) O[(size_t)(mt * 16 + fq * 4 + j) * 1024 + nt * 16 + fr] = (u16)pk_bf16(o[j], 0.f); }
        __syncthreads();
    }
}
template <bool HOOKED> __device__ __forceinline__ void run_gemms(const Params& p, unsigned char* lds, const int j0, const int j1) {
    unsigned char* ws = p.ws;
    for (int j = j0; j < j1; ++j) {
        pg8::Gemm g; EpiU<HOOKED> E; E.mode = 0; E.O = nullptr; E.Of = nullptr; E.X = nullptr; E.G = nullptr; E.ldc = 0; E.ldg = INW; E.sig_from = 1 << 30;
        u16* proj = (u16*)(ws + WS_PROJ); u16* merged = (u16*)(ws + WS_MERGED);
        const u16* BO = (const u16*)((unsigned char*)p.out + 67108864);
        if (j == 0) { g = pg8::Gemm{(const u16*)p.out, (const u16*)(ws + WS_WIN_T), S_, INW, D_}; E.O = proj; E.ldc = INW; E.sig_from = C_GA; }
        else if (j == 1) { g = pg8::Gemm{(const u16*)(ws + WS_MEMN), (const u16*)(ws + WS_WKV_T), 256, 1024, D_}; E.O = (u16*)(ws + WS_MEMKV); E.ldc = 1024; }
        else if (j == 2) { g = pg8::Gemm{BO, (const u16*)(ws + WS_WA_T), S_, D_, D_}; E.mode = 1; E.O = merged; E.ldc = D_; E.G = proj + C_GA; }
        else if (j == 5) { g = pg8::Gemm{merged, (const u16*)(ws + WS_WOUT_T), S_, D_, D_}; E.mode = 2; E.Of = p.out; E.X = p.x; E.ldc = D_; }
        else { g = pg8::Gemm{merged, (const u16*)(ws + WS_WQ_T), S_, D_, D_}; E.O = (u16*)(ws + WS_Q); E.ldc = D_; }
        pg8::StaticOrder So; So.init(g.M, g.N, (int)gridDim.x, (int)blockIdx.x);
        pg8::gemm_phase<EpiU<HOOKED>, pg8::StaticOrder>((PG8_LAS unsigned char*)lds, g, So, E, nullptr);
        __syncthreads();
    }
}
__global__ void __launch_bounds__(NTHR, 2) hybrid_fwd(Params p) {
    extern __shared__ __attribute__((aligned(16))) unsigned char lds[];
    cg::grid_group grid = cg::this_grid();
    if (p.ph_lo < 0) grid.sync();
    volatile LAS unsigned* bst = (volatile LAS unsigned*)((LAS unsigned char*)lds + (LDS_BYTES - 16));
    if (threadIdx.x < 4) bst[threadIdx.x] = 0u;
    __syncthreads();
    XcdBarrier xbar = xcd_barrier_post((unsigned*)(p.ws + WS_BAR), bst);
#define IN(k) (p.ph_lo <= (k) && (k) < p.ph_hi)
#define SEAM(k) do { if (IN(k) && IN((k) + 1)) xcd_barrier(xbar); } while (0)
#define RUNPH(k, ...) __VA_ARGS__ SEAM(k); if (DUPMASK & (1 << (k))) { __VA_ARGS__ SEAM(k); }
    RUNPH(0, if ((PH_MASK & 1) && IN(0)) phase_prep(p, lds);)
    RUNPH(1, if ((PH_MASK & 2) && IN(1)) { const bool first = ((blockIdx.x >> 3) & 1) != 0; if (first) late_transposes(p, lds); run_gemms<false>(p, lds, 0, 1); memkv_direct(p, lds); if (!first) late_transposes(p, lds); })
    RUNPH(2, if ((PH_MASK & 4) && IN(2)) phase_mix(p, lds);)
    RUNPH(3, if ((PH_MASK & 8) && IN(3)) { const bool first = ((blockIdx.x >> 3) & 1) != 0; if (first) convert_experts(p, 0); run_gemms<true>(p, lds, 2, 3); if (!first) convert_experts(p, 0); })
    RUNPH(4, if ((PH_MASK & 16) && IN(4)) { const bool first = ((blockIdx.x >> 3) & 1) != 0; if (first) convert_experts(p, 1); run_gemms<false>(p, lds, 5, 6); if (!first) convert_experts(p, 1); })
    RUNPH(5, if ((PH_MASK & 32) && IN(5)) phase_h2(p);)
    RUNPH(6, if ((PH_MASK & 64) && IN(6)) run_gemms<false>(p, lds, 6, 7);)
    RUNPH(7, if ((PH_MASK & 128) && IN(7)) phase_topk_peer(p, lds);)
#ifdef EXTRA_SYNCS
    for (int i = 0; i < EXTRA_SYNCS; ++i) xcd_barrier(xbar);
#endif
    (void)0;
#undef IN
#undef SEAM
}

#ifndef MK_LAUNCHES
#define MK_LAUNCHES 1
#endif
extern "C" void kernel_launch(void* const* d_in, const int* in_sizes, int n_in, void* d_out, int out_size, void* d_ws, size_t ws_size, hipStream_t stream) {
    static int grid = 0;
    if (grid == 0) {
        if (n_in != 25 || out_size != S_ * D_ || ws_size < WS_TOTAL) { fprintf(stderr, "kernel_launch: unexpected shapes (n_in %d out %d ws %zu need %zu)\n", n_in, out_size, ws_size, (size_t)WS_TOTAL); grid = -1; return; }
        int dev = 0, cus = 0, per_cu = 0;
        hipGetDevice(&dev); hipDeviceGetAttribute(&cus, hipDeviceAttributeMultiprocessorCount, dev);
        if (hipFuncSetAttribute((const void*)hybrid_fwd, hipFuncAttributeMaxDynamicSharedMemorySize, LDS_BYTES) != hipSuccess) { fprintf(stderr, "kernel_launch: hipFuncSetAttribute failed\n"); grid = -1; return; }
        if (hipOccupancyMaxActiveBlocksPerMultiprocessor(&per_cu, (const void*)hybrid_fwd, NTHR, LDS_BYTES) != hipSuccess || per_cu < 1) { fprintf(stderr, "kernel_launch: occupancy query gave %d\n", per_cu); per_cu = 1; }
        (void)hipGetLastError();
        grid = cus * per_cu;
    }
    if (grid < 0) return;
    Params p{};
    p.x = (const float*)d_in[0]; p.mem = (const float*)d_in[1]; p.pos = (const int*)d_in[2]; p.g_mix = (const float*)d_in[3]; p.w_in = (const float*)d_in[4];
    p.qg = (const float*)d_in[5]; p.kg = (const float*)d_in[6]; p.sinks = (const float*)d_in[7]; p.w_attn_o = (const float*)d_in[8]; p.dw_w = (const float*)d_in[9];
    p.dw_b = (const float*)d_in[10]; p.ln_g = (const float*)d_in[11]; p.ln_b = (const float*)d_in[12]; p.w_conv_o = (const float*)d_in[13]; p.g_mem = (const float*)d_in[14];
    p.w_mem_kv = (const float*)d_in[15]; p.mqg = (const float*)d_in[16]; p.mkg = (const float*)d_in[17]; p.w_mem_o = (const float*)d_in[18]; p.w_out = (const float*)d_in[19];
    p.g_ffn = (const float*)d_in[20]; p.w_query = (const float*)d_in[21]; p.sub_keys = (const float*)d_in[22]; p.eu = (const float*)d_in[23]; p.ev = (const float*)d_in[24];
    p.out = (float*)d_out; p.ws = (unsigned char*)d_ws;
#if MK_LAUNCHES == 1
    if (hipMemsetAsync((unsigned char*)d_ws + WS_BAR, 0, 16384, stream) != hipSuccess) { fprintf(stderr, "kernel_launch: memset of the barrier words failed\n"); return; }
    p.ph_lo = 0; p.ph_hi = N_PHASES;
    void* args[] = {&p};
    hipError_t e = hipLaunchCooperativeKernel((const void*)hybrid_fwd, dim3(grid), dim3(NTHR), args, LDS_BYTES, stream);
    if (e != hipSuccess) fprintf(stderr, "kernel_launch: cooperative launch failed: %s (grid %d)\n", hipGetErrorString(e), grid);
#else
    for (int ph = 0; ph < N_PHASES; ++ph) { p.ph_lo = ph; p.ph_hi = ph + 1; hipLaunchKernelGGL(hybrid_fwd, dim3(grid), dim3(NTHR), LDS_BYTES, stream, p); }
#endif
}
```

```cpp
#include <hip/hip_runtime.h>
#include <hip/hip_cooperative_groups.h>
#include <cstdio>
namespace cg = cooperative_groups;
namespace pg8 {
#define PG8_LAS __attribute__((address_space(3)))
typedef unsigned short bf16_t;
typedef short bf16x8 __attribute__((ext_vector_type(8)));
typedef float f32x4 __attribute__((ext_vector_type(4)));
typedef unsigned u32x4 __attribute__((ext_vector_type(4)));
constexpr int BM = 256, BK = 64, HALF = 128, HTB = HALF * BK * 2  , STAGE_BYTES = 8 * HTB, NXCD = 8, WGM = 4;

__host__ __device__ __forceinline__ int lds_byte(int r, int c) { const int st = (r >> 4) * 2 + (c >> 5), rr = r & 15, cc = c & 31, ob = rr * 64 + cc * 2; return st * 1024 + (ob ^ (((ob >> 9) & 1) << 5)); }
__host__ __device__ __forceinline__ void stage_rc(int b, int& R, int& C) { const int st = b / 1024, sb = b % 1024, swz = sb ^ (((sb >> 9) & 1) << 5); R = (st >> 1) * 16 + swz / 64; C = (st & 1) * 32 + (swz % 64) / 2; }
__host__ __device__ __forceinline__ int perm32(int rho) { const int n = rho >> 4, i = rho & 15; return 8 * (i >> 2) + 4 * n + (i & 3); }

struct Unit { int pm, pn; };
struct Gemm { const bf16_t* A; const bf16_t* Bt; int M, N, K; };

struct StaticOrder {
    int nM, nN, nwg, G, c;
    __host__ __device__ void init(int M, int N, int G_, int c_) { nM = M / BM; nN = N / BM; nwg = nM * nN; G = G_; c = c_; }
    __host__ __device__ bool next(int i, Unit& u) const {
        const long L = (long)i * G + c; if (L >= nwg) return false;
        int wgid = (int)L; { const int q = nwg / NXCD, r = nwg % NXCD, xcd = wgid % NXCD, off = wgid / NXCD; wgid = (xcd < r ? xcd * (q + 1) : r * (q + 1) + (xcd - r) * q) + off; }
        const int nig = WGM * nN, gid = wgid / nig, fm = gid * WGM, gsz = (nM - fm) < WGM ? (nM - fm) : WGM;
        u.pm = fm + ((wgid % nig) % gsz); u.pn = (wgid % nig) / gsz; return true;
    }
    __device__ __forceinline__ void a_ready(const Unit&) const {}
    __device__ __forceinline__ void done(const Unit&) const {}
};
__device__ __forceinline__ unsigned cvt_pk_bf16(float lo, float hi) { unsigned r; asm volatile("v_cvt_pk_bf16_f32 %0, %1, %2" : "=v"(r) : "v"(lo), "v"(hi)); return r; }
typedef float f32x2 __attribute__((ext_vector_type(2)));
template <class Epi, class Sched, bool STAMP = false>
__device__ __forceinline__ void gemm_phase(PG8_LAS unsigned char* lds, const Gemm g, const Sched& S, const Epi& E, unsigned long long* stamps) {
    const int tid = threadIdx.x, wid = __builtin_amdgcn_readfirstlane(tid >> 6), lane = tid & 63, wr = wid >> 2, wc = wid & 3, fr = lane & 15, fq = lane >> 4;
    const int K = g.K, nt = K / BK;
    int ts_lo = 0, ts_hi = 0, nts = 0; const unsigned long long rt_entry = STAMP ? (unsigned long long)wall_clock64() : 0ull;
#define PG8_STAMP() do { if (STAMP && wid == 0 && nts < 64) { const unsigned long long _c = (unsigned long long)clock64(); \
        ts_lo = (lane == nts) ? (int)(unsigned)_c : ts_lo; ts_hi = (lane == nts) ? (int)(unsigned)(_c >> 32) : ts_hi; ++nts; } } while (0)
    PG8_STAMP();
    unsigned voffA[2], voffB[2];
#pragma unroll
    for (int i = 0; i < 2; ++i) { int R, C; stage_rc(tid * 16 + i * 8192, R, C); const int Rb = ((R & ~31) + perm32(R & 31));
        voffA[i] = (unsigned)(R * K + C) * 2u; voffB[i] = (unsigned)(Rb * K + C) * 2u; }
    const size_t kstep = (size_t)(BK * 2);
    const size_t hstep = (size_t)HALF * K * 2;
    const size_t tstep = 2 * hstep;
    const unsigned ldsw = (unsigned)wid * 1024u;
    const int aoff = lds_byte(wr * 64 + fr, fq * 8), boff = lds_byte(wc * 32 + fr, fq * 8);
#define PG8_SA(b, h) (((b) * 2 + (h)) * HTB)
#define PG8_SB(b, h) ((4 + (b) * 2 + (h)) * HTB)
#define PG8_STAGE(bufoff, gbase, voff) do { _Pragma("unroll") for (int _i = 0; _i < 2; ++_i) \
        __builtin_amdgcn_global_load_lds((const unsigned*)((const char*)(gbase) + (voff)[_i]), (PG8_LAS unsigned*)(lds + (bufoff) + ldsw + _i * 8192), 16, 0, 0); } while (0)
#define PG8_LDA(dst, b, h) do { _Pragma("unroll") for (int m = 0; m < 4; ++m) _Pragma("unroll") for (int k = 0; k < 2; ++k) dst[m][k] = *(const PG8_LAS bf16x8*)(lds + PG8_SA(b, h) + aoff + m * 2048 + k * 1024); } while (0)
#define PG8_LDB(dst, b, h) do { _Pragma("unroll") for (int n = 0; n < 2; ++n) _Pragma("unroll") for (int k = 0; k < 2; ++k) dst[n][k] = *(const PG8_LAS bf16x8*)(lds + PG8_SB(b, h) + boff + n * 2048 + k * 1024); } while (0)
#define PG8_MMA(ai, bj, At, Bt) do { __builtin_amdgcn_s_setprio(1); _Pragma("unroll") for (int m = 0; m < 4; ++m) _Pragma("unroll") for (int n = 0; n < 2; ++n) _Pragma("unroll") for (int k = 0; k < 2; ++k) \
        acc[ai][bj][m][n] = __builtin_amdgcn_mfma_f32_16x16x32_bf16(Bt[n][k], At[m][k], acc[ai][bj][m][n], 0, 0, 0); __builtin_amdgcn_s_setprio(0); } while (0)
#define PG8_WAIT_V(n) asm volatile("s_waitcnt vmcnt(" #n ")" ::: "memory")
#define PG8_WAIT_L(n) asm volatile("s_waitcnt lgkmcnt(" #n ")" ::: "memory")
#define PG8_BAR __builtin_amdgcn_s_barrier()
#define PG8_SCHED __builtin_amdgcn_sched_barrier(0)
    Unit cur, nxt; int ui = 0;
    if (!S.next(0, cur)) return;
    f32x4 acc[2][2][4][2];
#pragma unroll
    for (int a = 0; a < 2; ++a)
#pragma unroll
        for (int b = 0; b < 2; ++b)
#pragma unroll
            for (int m = 0; m < 4; ++m)
#pragma unroll
                for (int n = 0; n < 2; ++n) acc[a][b][m][n] = (f32x4){0.f, 0.f, 0.f, 0.f};
    bf16x8 At[4][2], B0[2][2], B1[2][2];
    const char* cA = (const char*)g.A + (size_t)cur.pm * tstep; const char* cB = (const char*)g.Bt + (size_t)cur.pn * tstep;
    S.a_ready(cur);
    PG8_STAGE(PG8_SB(0, 0), cB, voffB); PG8_STAGE(PG8_SA(0, 0), cA, voffA); PG8_STAGE(PG8_SB(0, 1), cB + hstep, voffB); PG8_STAGE(PG8_SA(0, 1), cA + hstep, voffA);
    if (wr == 1) PG8_BAR;
    PG8_WAIT_V(4); PG8_BAR;
    PG8_STAGE(PG8_SB(1, 0), cB + kstep, voffB); PG8_STAGE(PG8_SA(1, 0), cA + kstep, voffA); PG8_STAGE(PG8_SB(1, 1), cB + hstep + kstep, voffB);
    PG8_WAIT_V(6); PG8_BAR;
    PG8_STAMP();
    for (;;) {
        const bool has_next = S.next(ui + 1, nxt);
        const char* nA = has_next ? (const char*)g.A + (size_t)nxt.pm * tstep : cA; const char* nB = has_next ? (const char*)g.Bt + (size_t)nxt.pn * tstep : cB;
        for (int t = 0; t < nt; t += 2) {
            const bool last = (t == nt - 2);
            const char* a1 = cA + (size_t)(t + 1) * kstep;
            const char* a2 = last ? nA : cA + (size_t)(t + 2) * kstep; const char* b2 = last ? nB : cB + (size_t)(t + 2) * kstep;
            const char* a3 = a2 + kstep; const char* b3 = b2 + kstep;
            E.hook(acc, cur, t, wr, wc, fr, fq);
            if (last && has_next) S.a_ready(nxt);
            PG8_LDB(B0, 0, 0); PG8_SCHED; PG8_LDA(At, 0, 0); PG8_STAGE(PG8_SA(1, 1), a1 + hstep, voffA);
            PG8_WAIT_L(8); PG8_BAR; PG8_WAIT_L(0); PG8_MMA(0, 0, At, B0); PG8_BAR; PG8_SCHED;
            PG8_LDB(B1, 0, 1); PG8_STAGE(PG8_SB(0, 0), b2, voffB);
            PG8_BAR; PG8_WAIT_L(0); PG8_MMA(0, 1, At, B1); PG8_BAR;
            PG8_LDA(At, 0, 1); PG8_STAGE(PG8_SA(0, 0), a2, voffA);
            PG8_BAR; PG8_WAIT_L(0); PG8_MMA(1, 0, At, B0); PG8_BAR; PG8_SCHED;
            PG8_STAGE(PG8_SB(0, 1), b2 + hstep, voffB);
            PG8_WAIT_V(6); PG8_BAR; PG8_MMA(1, 1, At, B1); PG8_BAR;
            PG8_LDB(B0, 1, 0); PG8_SCHED; PG8_LDA(At, 1, 0); PG8_STAGE(PG8_SA(0, 1), a2 + hstep, voffA);
            PG8_WAIT_L(8); PG8_BAR; PG8_WAIT_L(0); PG8_MMA(0, 0, At, B0); PG8_BAR; PG8_SCHED;
            PG8_LDB(B1, 1, 1); PG8_STAGE(PG8_SB(1, 0), b3, voffB);
            PG8_BAR; PG8_WAIT_L(0); PG8_MMA(0, 1, At, B1); PG8_BAR;
            PG8_LDA(At, 1, 1); PG8_STAGE(PG8_SA(1, 0), a3, voffA);
            PG8_BAR; PG8_WAIT_L(0); PG8_MMA(1, 0, At, B0); PG8_BAR; PG8_SCHED;
            PG8_STAGE(PG8_SB(1, 1), b3 + hstep, voffB);
            PG8_WAIT_V(6); PG8_BAR; PG8_MMA(1, 1, At, B1); PG8_BAR;
        }
        PG8_STAMP();
        if constexpr (!Epi::AFTER_DRAIN) { E(acc, cur, wr, wc, fr, fq); S.done(cur); }
        PG8_STAMP();
        if (!has_next) break;
#pragma unroll
        for (int a = 0; a < 2; ++a)
#pragma unroll
            for (int b = 0; b < 2; ++b)
#pragma unroll
                for (int m = 0; m < 4; ++m)
#pragma unroll
                    for (int n = 0; n < 2; ++n) acc[a][b][m][n] = (f32x4){0.f, 0.f, 0.f, 0.f};
        cur = nxt; cA = nA; cB = nB; ++ui;
    }
    PG8_WAIT_V(0);
    if (wr == 0) PG8_BAR;
    PG8_BAR;
    if constexpr (Epi::AFTER_DRAIN) { E.fused(acc, cur, wr, wc, fr, fq, lds, wid, lane); S.done(cur); }
    PG8_STAMP();
    if (STAMP && wid == 0) { stamps[lane] = lane < nts ? (((unsigned long long)(unsigned)ts_hi << 32) | (unsigned)ts_lo) : 0ull;
        if (lane == 62) stamps[62] = rt_entry; if (lane == 63) stamps[63] = (unsigned long long)wall_clock64(); }
#undef PG8_STAMP
#undef PG8_SA
#undef PG8_SB
#undef PG8_STAGE
#undef PG8_LDA
#undef PG8_LDB
#undef PG8_MMA
#undef PG8_WAIT_V
#undef PG8_WAIT_L
#undef PG8_BAR
#undef PG8_SCHED
}
}

#define XB_TMO      128
#define XB_XCNT(j)  (256  + 64 * (j))
#define XB_XSUB(j)  (1280 + 64 * (j))
#define XB_XGEN(j)  (2304 + 64 * (j))
#define XB_TOP      3328
#define XB_TOPGEN   3392
#define XCD_BAR_WORDS 3456
#define XB_SPIN_CAP (1u << 18)
#define LAS __attribute__((address_space(3)))

__device__ __forceinline__ unsigned xb_ld(unsigned* p)              { return __hip_atomic_load(p, __ATOMIC_RELAXED, __HIP_MEMORY_SCOPE_AGENT); }
__device__ __forceinline__ unsigned xb_add(unsigned* p, unsigned v) { return __hip_atomic_fetch_add(p, v, __ATOMIC_RELAXED, __HIP_MEMORY_SCOPE_AGENT); }
__device__ __forceinline__ unsigned xb_xcc_id() { return (unsigned)__builtin_amdgcn_s_getreg((3 << 11) | 20) & 0xFu; }
#define XB_SPIN(cond, bar) do { unsigned _sp = 0; while (cond) { __builtin_amdgcn_s_sleep(1); \
    if ((++_sp & 255u) == 0u) { if (xb_ld(&(bar)[XB_TMO])) break; if (_sp > XB_SPIN_CAP) { atomicAdd(&(bar)[XB_TMO], 1u); break; } } } } while (0)

struct XcdBarrier {
    unsigned* bar; unsigned x;
    volatile LAS unsigned* st;
};

__device__ __forceinline__ XcdBarrier xcd_barrier_post(unsigned* bar, volatile LAS unsigned* st) {
    XcdBarrier b; b.bar = bar; b.x = xb_xcc_id(); b.st = st;
    if (threadIdx.x == 0) (void)xb_add(&bar[XB_XCNT(b.x)], 1u);
    return b;
}
__device__ __forceinline__ void xcd_barrier_complete(unsigned* bar, unsigned x, unsigned& nloc, unsigned& nx) {
    const unsigned G = gridDim.x * gridDim.y * gridDim.z;
    unsigned sum, cnt, mine, sp = 0u;
    for (;;) {
        sum = 0u; cnt = 0u; mine = 0u;
#pragma unroll
        for (unsigned j = 0; j < 16; ++j) { const unsigned c = xb_ld(&bar[XB_XCNT(j)]); sum += c; cnt += (c > 0u) ? 1u : 0u; mine = (j == x) ? c : mine; }
        if (sum == G) break;
        __builtin_amdgcn_s_sleep(1);
        if ((++sp & 255u) == 0u) { if (xb_ld(&bar[XB_TMO])) break; if (sp > XB_SPIN_CAP) { atomicAdd(&bar[XB_TMO], 1u); break; } }
    }
    nloc = mine > 0u ? mine : 1u; nx = cnt > 0u ? cnt : 1u;
}

__device__ __forceinline__ void xcd_barrier(const XcdBarrier& b) {
    asm volatile("s_waitcnt vmcnt(0)" ::: "memory");
    __syncthreads();
    if (threadIdx.x == 0) {
        unsigned* bar = b.bar;
        __builtin_amdgcn_s_waitcnt(0);
        unsigned nloc = b.st[0], nx = b.st[1];
        if (nloc == 0u) { xcd_barrier_complete(bar, b.x, nloc, nx); b.st[0] = nloc; b.st[1] = nx; }
        const unsigned old = xb_add(&bar[XB_XSUB(b.x)], 1u);
        const unsigned gen = old / nloc;
        if (old + 1u == (gen + 1u) * nloc) {
            __builtin_amdgcn_fence(__ATOMIC_RELEASE, "agent");
            asm volatile("s_waitcnt vmcnt(0)" ::: "memory");
            const unsigned og = xb_add(&bar[XB_TOP], 1u);
            const unsigned tg = og / nx;
            if (og + 1u == (tg + 1u) * nx) xb_add(&bar[XB_TOPGEN], 1u);
            else XB_SPIN(xb_ld(&bar[XB_TOPGEN]) == tg, bar);
            __builtin_amdgcn_fence(__ATOMIC_ACQUIRE, "agent");
            xb_add(&bar[XB_XGEN(b.x)], 1u);
            asm volatile("s_waitcnt vmcnt(0)" ::: "memory");
        } else {
            XB_SPIN(xb_ld(&bar[XB_XGEN(b.x)]) == gen, bar);
            __builtin_amdgcn_fence(__ATOMIC_ACQUIRE, "agent");
            asm volatile("s_waitcnt vmcnt(0)" ::: "memory");
        }
    }
    __syncthreads();
}

typedef unsigned short u16;
typedef unsigned int u32;
typedef short bf16x8 __attribute__((ext_vector_type(8)));
typedef float f32x4 __attribute__((ext_vector_type(4)));
typedef u32 u32x4 __attribute__((ext_vector_type(4)));
typedef u32 u32x2 __attribute__((ext_vector_type(2)));
typedef __bf16 bf16x2_t __attribute__((ext_vector_type(2)));

constexpr int S_ = 16384, D_ = 2048, INW = 9216;
constexpr int C_Q = 0, C_K = 1024, C_V = 1280, C_CA = 1536, C_CB = 2048, C_MQ = 2560, C_GA = 3072, C_GC = 5120, C_GM = 7168;
constexpr float EPS_ = 1e-6f, LOG2E = 1.4426950408889634f;
constexpr int LDS_BYTES = 155648, NTHR = 512;

constexpr size_t WS_WIN_T = 4096;
constexpr size_t WS_WA_T = WS_WIN_T + (size_t)INW * D_ * 2;
constexpr size_t WS_WC_T = WS_WA_T + (size_t)2048 * 1024 * 2;
constexpr size_t WS_WM_T = WS_WC_T + (size_t)2048 * 512 * 2;
constexpr size_t WS_WKV_T = WS_WM_T + (size_t)2048 * 512 * 2;
constexpr size_t WS_WOUT_T = WS_WKV_T + (size_t)1024 * 2048 * 2;
constexpr size_t WS_WQ_T = WS_WOUT_T + (size_t)2048 * 2048 * 2;
constexpr size_t WS_SK = WS_WQ_T + (size_t)2048 * 2048 * 2;
constexpr size_t WS_MEMN = WS_SK + (size_t)16 * 128 * 128 * 2;
constexpr size_t WS_MEMKV = WS_MEMN + (size_t)256 * 2048 * 2;
constexpr size_t WS_COS = WS_MEMKV + (size_t)256 * 1024 * 2;
constexpr size_t WS_SIN = WS_COS + (size_t)S_ * 32 * 4;
constexpr size_t WS_MERGED = WS_SIN + (size_t)S_ * 32 * 4;
constexpr size_t WS_PROJ = WS_MERGED + (size_t)S_ * D_ * 2;
constexpr size_t WS_EV = WS_PROJ + (size_t)16384 * 2048;
constexpr size_t WS_Q = WS_EV + (size_t)16384 * 2048;
constexpr size_t WS_SI = WS_Q + (size_t)S_ * 2048 * 2;
constexpr size_t WS_SG = WS_SI + (size_t)S_ * 128 * 4;
constexpr size_t WS_SGU = WS_SG + (size_t)S_ * 128 * 4;
constexpr size_t WS_END = WS_PROJ + (size_t)S_ * INW * 2;
constexpr size_t WS_BAR = WS_END;
constexpr size_t WS_EU = WS_BAR + 16384;
constexpr size_t WS_SUI = WS_EU + (size_t)16384 * 3072;
constexpr size_t WS_SVI = WS_SUI + (size_t)16384 * 4;
constexpr size_t WS_TOTAL = WS_SVI + (size_t)16384 * 4;
static_assert(WS_SGU + (size_t)S_ * 128 * 4 <= WS_END, "peer scratch must fit the dead proj region");

struct Params {
    const float* x; const float* mem; const int* pos; const float* g_mix; const float* w_in; const float* qg; const float* kg; const float* sinks;
    const float* w_attn_o; const float* dw_w; const float* dw_b; const float* ln_g; const float* ln_b; const float* w_conv_o; const float* g_mem;
    const float* w_mem_kv; const float* mqg; const float* mkg; const float* w_mem_o; const float* w_out; const float* g_ffn; const float* w_query;
    const float* sub_keys; const float* eu; const float* ev;
    float* out; unsigned char* ws; int ph_lo, ph_hi;
};

__device__ __forceinline__ u32 pk_bf16(float lo, float hi) { u32 r; asm("v_cvt_pk_bf16_f32 %0, %1, %2" : "=v"(r) : "v"(lo), "v"(hi)); return r; }
__device__ __forceinline__ float bf_lo(u32 w) { return __uint_as_float(w << 16); }
__device__ __forceinline__ float bf_hi(u32 w) { return __uint_as_float(w & 0xffff0000u); }
__device__ __forceinline__ float fast_sigmoid(float x) { return __builtin_amdgcn_rcpf(1.f + __builtin_amdgcn_exp2f(-x * LOG2E)); }
template <int CTRL> __device__ __forceinline__ float dppf(float v) { return __builtin_bit_cast(float, __builtin_amdgcn_update_dpp(0, __builtin_bit_cast(int, v), CTRL, 0xf, 0xf, true)); }
__device__ __forceinline__ float row_sum16(float v) { v += dppf<0xB1>(v); v += dppf<0x4E>(v); v += dppf<0x141>(v); v += dppf<0x140>(v); return v; }
__device__ __forceinline__ float grp8_sum(float v) { v += dppf<0xB1>(v); v += dppf<0x4E>(v); v += dppf<0x141>(v); return v; }
__device__ __forceinline__ float shx(float v, int lane, int m) { return __builtin_bit_cast(float, __builtin_amdgcn_ds_bpermute((lane ^ m) << 2, __builtin_bit_cast(int, v))); }
__device__ __forceinline__ float rdlane(float v, int l) { return __builtin_bit_cast(float, __builtin_amdgcn_readlane(__builtin_bit_cast(int, v), l)); }
__device__ __forceinline__ float wave_sum(float v) { v = row_sum16(v); return (rdlane(v, 0) + rdlane(v, 16)) + (rdlane(v, 32) + rdlane(v, 48)); }
__device__ __forceinline__ float dot2bf(u32 a, u32 b, float acc) { return __builtin_amdgcn_fdot2_f32_bf16(__builtin_bit_cast(bf16x2_t, a), __builtin_bit_cast(bf16x2_t, b), acc, false); }
__device__ __forceinline__ f32x4 mfma16(bf16x8 a, bf16x8 b, f32x4 c) { return __builtin_amdgcn_mfma_f32_16x16x32_bf16(a, b, c, 0, 0, 0); }
template <int CTRL> __device__ __forceinline__ float dppmax(float v) { return fmaxf(v, dppf<CTRL>(v)); }
__device__ __forceinline__ float wave_max(float v) { v = dppmax<0xB1>(v); v = dppmax<0x4E>(v); v = dppmax<0x141>(v); v = dppmax<0x140>(v); return fmaxf(fmaxf(rdlane(v, 0), rdlane(v, 16)), fmaxf(rdlane(v, 32), rdlane(v, 48))); }
typedef float f32x2 __attribute__((ext_vector_type(2)));
typedef float v16f __attribute__((ext_vector_type(16)));
typedef float v32f __attribute__((ext_vector_type(32)));
typedef unsigned v6u __attribute__((ext_vector_type(6)));
#ifndef FP6_INTERLEAVED
#define FP6_INTERLEAVED 1
#endif
__device__ __forceinline__ u32 mono_key(float x) { u32 u = __float_as_uint(x); return (u & 0x80000000u) ? ~u : (u | 0x80000000u); }

template <bool HOOKED> struct EpiU {
    static constexpr bool PERM = true, AFTER_DRAIN = false;
    int mode;
    u16* O; float* Of; const float* X; const u16* G; int ldc; int ldg; int sig_from;
    __device__ __forceinline__ void hook(pg8::f32x4 (&acc)[2][2][4][2], const pg8::Unit& u, int t, int wr, int wc, int fr, int fq) const {
        if (!HOOKED) return;
        if (t != 16 && t != 24) return;
        int z = 0; asm volatile("" : "+v"(z));
        const unsigned char* gc = (const unsigned char*)(G + (t == 16 ? 0 : 2048));
        const int row0 = u.pm * 256 + wr * 64 + fr + z, col0 = u.pn * 256 + wc * 32 + 8 * fq;
        const u32 off0 = ((u32)row0 * (u32)INW + (u32)col0) * 2u;
#pragma unroll
        for (int ai = 0; ai < 2; ++ai) {
            u32x4 ga[4][2], gb[4][2];
#pragma unroll
            for (int m = 0; m < 4; ++m)
#pragma unroll
                for (int bj = 0; bj < 2; ++bj) { const unsigned char* gp = gc + (off0 + (u32)(((ai * 128 + m * 16) * INW + bj * 128) * 2));
                    ga[m][bj] = *(const u32x4*)gp; gb[m][bj] = *(const u32x4*)(gp + 4096); }
#pragma unroll
            for (int m = 0; m < 4; ++m)
#pragma unroll
                for (int bj = 0; bj < 2; ++bj) { const u32x4 a = ga[m][bj], b = gb[m][bj];
                    acc[ai][bj][m][0][0] *= bf_lo(a.x) * __builtin_amdgcn_rcpf(bf_lo(b.x)); acc[ai][bj][m][0][1] *= bf_hi(a.x) * __builtin_amdgcn_rcpf(bf_hi(b.x));
                    acc[ai][bj][m][0][2] *= bf_lo(a.y) * __builtin_amdgcn_rcpf(bf_lo(b.y)); acc[ai][bj][m][0][3] *= bf_hi(a.y) * __builtin_amdgcn_rcpf(bf_hi(b.y));
                    acc[ai][bj][m][1][0] *= bf_lo(a.z) * __builtin_amdgcn_rcpf(bf_lo(b.z)); acc[ai][bj][m][1][1] *= bf_hi(a.z) * __builtin_amdgcn_rcpf(bf_hi(b.z));
                    acc[ai][bj][m][1][2] *= bf_lo(a.w) * __builtin_amdgcn_rcpf(bf_lo(b.w)); acc[ai][bj][m][1][3] *= bf_hi(a.w) * __builtin_amdgcn_rcpf(bf_hi(b.w)); }
            __builtin_amdgcn_sched_barrier(0); }
    }
    __device__ __forceinline__ void operator()(const pg8::f32x4 (&acc)[2][2][4][2], const pg8::Unit& u, int wr, int wc, int fr, int fq) const {
        const int row0 = u.pm * 256 + wr * 64 + fr, col0 = u.pn * 256 + wc * 32 + 8 * fq;
        if (mode == 0) {
            const bool sg = (u.pn * 256) >= sig_from;
#pragma unroll
            for (int ai = 0; ai < 2; ++ai)
#pragma unroll
                for (int m = 0; m < 4; ++m) { u16* rowp = O + (size_t)(row0 + ai * 128 + m * 16) * ldc + col0;
#pragma unroll
                    for (int bj = 0; bj < 2; ++bj) { f32x4 v0 = acc[ai][bj][m][0], v1 = acc[ai][bj][m][1];
                        if (sg) {
#pragma unroll
                            for (int j = 0; j < 4; ++j) { v0[j] = fmaxf(fast_sigmoid(v0[j]), 1e-30f); v1[j] = fmaxf(fast_sigmoid(v1[j]), 1e-30f); } }
                        u32x4 w; w.x = pk_bf16(v0[0], v0[1]); w.y = pk_bf16(v0[2], v0[3]); w.z = pk_bf16(v1[0], v1[1]); w.w = pk_bf16(v1[2], v1[3]);
                        *(u32x4*)(rowp + bj * 128) = w; } }
        } else if (mode == 1) {
#pragma unroll
            for (int ai = 0; ai < 2; ++ai) { u32x4 g[4][2];
#pragma unroll
                for (int m = 0; m < 4; ++m)
#pragma unroll
                    for (int bj = 0; bj < 2; ++bj) g[m][bj] = *(const u32x4*)(G + 4096 + (size_t)(row0 + ai * 128 + m * 16) * ldg + col0 + bj * 128);
#pragma unroll
                for (int m = 0; m < 4; ++m) { const size_t r = (size_t)(row0 + ai * 128 + m * 16);
#pragma unroll
                    for (int bj = 0; bj < 2; ++bj) { const f32x4 v0 = acc[ai][bj][m][0], v1 = acc[ai][bj][m][1]; const u32x4 gg = g[m][bj];
                        u32x4 w;
                        w.x = pk_bf16(bf_lo(gg.x) * v0[0], bf_hi(gg.x) * v0[1]); w.y = pk_bf16(bf_lo(gg.y) * v0[2], bf_hi(gg.y) * v0[3]);
                        w.z = pk_bf16(bf_lo(gg.z) * v1[0], bf_hi(gg.z) * v1[1]); w.w = pk_bf16(bf_lo(gg.w) * v1[2], bf_hi(gg.w) * v1[3]);
                        *(u32x4*)(O + r * ldc + col0 + bj * 128) = w; } } }
        } else {
#pragma unroll
            for (int ai = 0; ai < 2; ++ai) { f32x4 xv[4][2][2];
#pragma unroll
                for (int m = 0; m < 4; ++m)
#pragma unroll
                    for (int bj = 0; bj < 2; ++bj) { const size_t o = (size_t)(row0 + ai * 128 + m * 16) * ldc + col0 + bj * 128;
                        xv[m][bj][0] = *(const f32x4*)(X + o); xv[m][bj][1] = *(const f32x4*)(X + o + 4); }
#pragma unroll
                for (int m = 0; m < 4; ++m)
#pragma unroll
                    for (int bj = 0; bj < 2; ++bj) { const size_t o = (size_t)(row0 + ai * 128 + m * 16) * ldc + col0 + bj * 128;
                        *(f32x4*)(Of + o) = xv[m][bj][0] + acc[ai][bj][m][0]; *(f32x4*)(Of + o + 4) = xv[m][bj][1] + acc[ai][bj][m][1]; } }
        }
    }
};

__device__ __forceinline__ void cvt_tr_tile4(const float* __restrict__ src, u16* __restrict__ dst, int R, int C, int tile0, float* T, int ldd) {
    const int ntc = C >> 6, tid = threadIdx.x;
    f32x4 v[4][2];
#pragma unroll
    for (int q = 0; q < 4; ++q) { const int tile = tile0 + q, tr = tile / ntc, tc = tile - tr * ntc;
#pragma unroll
        for (int i = 0; i < 2; ++i) { const int idx = tid + i * NTHR, r = idx >> 4, c4 = idx & 15; v[q][i] = *(const f32x4*)(src + (size_t)(tr * 64 + r) * C + tc * 64 + c4 * 4); } }
#pragma unroll
    for (int q = 0; q < 4; ++q)
#pragma unroll
        for (int i = 0; i < 2; ++i) { const int idx = tid + i * NTHR, r = idx >> 4, c4 = idx & 15; float* t = T + q * 4160 + r * 65 + c4 * 4; t[0] = v[q][i][0]; t[1] = v[q][i][1]; t[2] = v[q][i][2]; t[3] = v[q][i][3]; }
    __syncthreads();
#pragma unroll
    for (int q = 0; q < 4; ++q) { const int tile = tile0 + q, tr = tile / ntc, tc = tile - tr * ntc; const int c = tid >> 3, r0 = (tid & 7) * 8; float x[8];
#pragma unroll
        for (int j = 0; j < 8; ++j) x[j] = T[q * 4160 + (r0 + j) * 65 + c];
        u32x4 w; w.x = pk_bf16(x[0], x[1]); w.y = pk_bf16(x[2], x[3]); w.z = pk_bf16(x[4], x[5]); w.w = pk_bf16(x[6], x[7]);
        *(u32x4*)(dst + (size_t)(tc * 64 + c) * ldd + tr * 64 + r0) = w; }
    __syncthreads();
}
template <int NR> __device__ __forceinline__ void rms_rows(const float* __restrict__ x, const float* __restrict__ g, u16* __restrict__ out, size_t rstride, int lane) {
    f32x4 v[NR][8]; float ss[NR];
#pragma unroll
    for (int q = 0; q < NR; ++q) { ss[q] = 0.f;
#pragma unroll
        for (int i = 0; i < 8; ++i) v[q][i] = ((const f32x4*)(x + q * rstride))[i * 64 + lane]; }
#pragma unroll
    for (int q = 0; q < NR; ++q) {
#pragma unroll
        for (int i = 0; i < 8; ++i) ss[q] += v[q][i][0] * v[q][i][0] + v[q][i][1] * v[q][i][1] + v[q][i][2] * v[q][i][2] + v[q][i][3] * v[q][i][3];
        ss[q] = rsqrtf(wave_sum(ss[q]) * (1.f / 2048.f) + EPS_); }
#pragma unroll
    for (int i = 0; i < 8; ++i) { const f32x4 gg = ((const f32x4*)g)[i * 64 + lane];
#pragma unroll
        for (int q = 0; q < NR; ++q) { const float rs = ss[q];
            u32x2 w; w.x = pk_bf16(v[q][i][0] * rs * gg[0], v[q][i][1] * rs * gg[1]); w.y = pk_bf16(v[q][i][2] * rs * gg[2], v[q][i][3] * rs * gg[3]);
            ((u32x2*)(out + q * rstride))[i * 64 + lane] = w; } }
}
__device__ __forceinline__ void sincos_d(double r, double& s, double& c) {
    const double r2 = r * r; double ts = 1.0, tc = 1.0;
    double ss = 0.0, cc = 0.0;
    double term_s = 1.0, term_c = 1.0; ss = 1.0; cc = 1.0;
#pragma unroll
    for (int k = 1; k <= 15; ++k) { term_c *= -r2 / (double)((2 * k - 1) * (2 * k)); term_s *= -r2 / (double)((2 * k) * (2 * k + 1)); cc += term_c; ss += term_s; }
    (void)ts; (void)tc;
    s = r * ss; c = cc;
}
__device__ __forceinline__ void phase_prep(const Params& p, unsigned char* lds) {
    float* T = (float*)lds;
    unsigned char* ws = p.ws;
    const int tid = threadIdx.x, lane = tid & 63, wave = tid >> 6;
    for (int j = blockIdx.x * 4; j < 4608 + 512; j += gridDim.x * 4) {
        if (j < 4608) cvt_tr_tile4(p.w_in, (u16*)(ws + WS_WIN_T), 2048, INW, j, T, 2048);
        else cvt_tr_tile4(p.w_mem_kv, (u16*)(ws + WS_WKV_T), 2048, 1024, j - 4608, T, 2048);
    }
    { const int nw = gridDim.x * 8, w0 = blockIdx.x * 8 + wave;
        for (int r = w0; r < S_; r += 4 * nw) {
            if (r + 3 * nw < S_) rms_rows<4>(p.x + (size_t)r * D_, p.g_mix, (u16*)p.out + (size_t)r * D_, (size_t)nw * D_, lane);
            else for (int q = r; q < S_; q += nw) rms_rows<1>(p.x + (size_t)q * D_, p.g_mix, (u16*)p.out + (size_t)q * D_, 0, lane); }
        for (int r = w0; r < 256; r += nw) rms_rows<1>(p.mem + (size_t)r * D_, p.g_mem, (u16*)(ws + WS_MEMN) + (size_t)r * D_, 0, lane); }
}

#ifndef MIXDUP
#define MIXDUP 0
#endif
#ifndef MIX_MASK
#define MIX_MASK 7
#endif
struct SwaPre { u32x2 kra[3], krb[3]; f32x4 kcs[3], ksn[3]; u32x4 vr[3]; };
__device__ __forceinline__ void swa_preload(const Params& p, const int item, const int tid_in, SwaPre& R) {
    int zi = 0; asm volatile("" : "+v"(zi)); const int tid = tid_in + zi;
    const u16* __restrict__ proj = (const u16*)(p.ws + WS_PROJ);
    const float* __restrict__ COS = (const float*)(p.ws + WS_COS); const float* __restrict__ SIN = (const float*)(p.ws + WS_SIN);
    const int qt = item >> 2, kh = item & 3, t0 = qt * 64;
#pragma unroll
    for (int ps = 0; ps < 3; ++ps) { const int idx = ps * NTHR + tid, key = idx >> 3, l8 = idx & 7; int t = t0 - 128 + key; t = t < 0 ? 0 : t;
        const u16* kp = proj + (size_t)t * INW + C_K + kh * 64 + l8 * 4;
        R.kra[ps] = *(const u32x2*)kp; R.krb[ps] = *(const u32x2*)(kp + 32); R.kcs[ps] = *(const f32x4*)(COS + t * 32 + l8 * 4); R.ksn[ps] = *(const f32x4*)(SIN + t * 32 + l8 * 4);
        const int kb = idx >> 6, vkey = (kb >> 1) * 16 + (idx & 15), c8 = (kb & 1) * 4 + ((idx >> 4) & 3); int tv = t0 - 128 + vkey; tv = tv < 0 ? 0 : tv;
        R.vr[ps] = *(const u32x4*)(proj + (size_t)tv * INW + C_V + kh * 64 + c8 * 8); }
}
__device__ __forceinline__ void swa_item(const Params& p, int item, unsigned char* lds, float mbound_nat, const int tid_in, SwaPre& R, const int next_item) {
    int zi = 0; asm volatile("" : "+v"(zi)); const int tid = tid_in + zi;
    const u16* __restrict__ proj = (const u16*)(p.ws + WS_PROJ);
    const float* __restrict__ COS = (const float*)(p.ws + WS_COS); const float* __restrict__ SIN = (const float*)(p.ws + WS_SIN);
    u16* Ks = (u16*)lds;
    constexpr int VSTR = 200; u16* Vt = (u16*)(lds + 27648);
    const int qt = item >> 2, kh = item & 3, t0 = qt * 64;
    const int lane = tid & 63, wave = tid >> 6, fr = lane & 15, fq = lane >> 4;
    const f32x4 g1 = *(const f32x4*)(p.kg + (tid & 7) * 4), g2 = *(const f32x4*)(p.kg + 32 + (tid & 7) * 4);
#pragma unroll
    for (int ps = 0; ps < 3; ++ps) { const int idx = ps * NTHR + tid, key = idx >> 3, l8 = idx & 7, t = t0 - 128 + key;
        const bool ok = t >= 0; const u32x2 a = R.kra[ps], b = R.krb[ps];
        float x[8];
        x[0] = ok ? bf_lo(a.x) : 0.f; x[1] = ok ? bf_hi(a.x) : 0.f; x[2] = ok ? bf_lo(a.y) : 0.f; x[3] = ok ? bf_hi(a.y) : 0.f;
        x[4] = ok ? bf_lo(b.x) : 0.f; x[5] = ok ? bf_hi(b.x) : 0.f; x[6] = ok ? bf_lo(b.y) : 0.f; x[7] = ok ? bf_hi(b.y) : 0.f;
        const f32x4 cs = R.kcs[ps], sn = R.ksn[ps];
        float ss = 0.f;
#pragma unroll
        for (int j = 0; j < 8; ++j) ss += x[j] * x[j];
        ss = grp8_sum(ss);
        const float rs = rsqrtf(ss * (1.f / 64.f) + EPS_);
        float o1[4], o2[4];
#pragma unroll
        for (int j = 0; j < 4; ++j) { const float y1 = x[j] * rs * g1[j], y2 = x[4 + j] * rs * g2[j]; o1[j] = y1 * cs[j] - y2 * sn[j]; o2[j] = y2 * cs[j] + y1 * sn[j]; }
        u32x2 w1, w2; w1.x = pk_bf16(o1[0], o1[1]); w1.y = pk_bf16(o1[2], o1[3]); w2.x = pk_bf16(o2[0], o2[1]); w2.y = pk_bf16(o2[2], o2[3]);
        *(u32x2*)(Ks + key * 72 + l8 * 4) = w1; *(u32x2*)(Ks + key * 72 + 32 + l8 * 4) = w2; }
#pragma unroll
    for (int ps = 0; ps < 3; ++ps) { const int idx = ps * NTHR + tid, kb = idx >> 6, key = (kb >> 1) * 16 + (idx & 15), c8 = (kb & 1) * 4 + ((idx >> 4) & 3), t = t0 - 128 + key;
        u32x4 w = R.vr[ps]; if (t < 0) w = (u32x4){0u, 0u, 0u, 0u};
        u16* vp = Vt + (c8 * 8) * VSTR + key;
        vp[0] = (u16)w.x; vp[VSTR] = (u16)(w.x >> 16); vp[2 * VSTR] = (u16)w.y; vp[3 * VSTR] = (u16)(w.y >> 16);
        vp[4 * VSTR] = (u16)w.z; vp[5 * VSTR] = (u16)(w.z >> 16); vp[6 * VSTR] = (u16)w.w; vp[7 * VSTR] = (u16)(w.w >> 16); }
    __syncthreads();
    if (next_item >= 0) swa_preload(p, next_item, tid_in, R);
    {
        const int g = wave >> 1, half = wave & 1, head = kh * 4 + g, tw0 = t0 + half * 32;
        const float sinkv = p.sinks[head];
        const float mb = fmaxf(mbound_nat, sinkv) * LOG2E;
        const float qscale = 0.125f * LOG2E;
        bf16x8 qf[2][2];
#pragma unroll
        for (int mt = 0; mt < 2; ++mt) { const int t = tw0 + mt * 16 + fr;
            const u16* qp = proj + (size_t)t * INW + C_Q + head * 64 + fq * 8;
            const u32x4 a = *(const u32x4*)qp, b = *(const u32x4*)(qp + 32);
            float x1[8], x2[8];
            x1[0] = bf_lo(a.x); x1[1] = bf_hi(a.x); x1[2] = bf_lo(a.y); x1[3] = bf_hi(a.y); x1[4] = bf_lo(a.z); x1[5] = bf_hi(a.z); x1[6] = bf_lo(a.w); x1[7] = bf_hi(a.w);
            x2[0] = bf_lo(b.x); x2[1] = bf_hi(b.x); x2[2] = bf_lo(b.y); x2[3] = bf_hi(b.y); x2[4] = bf_lo(b.z); x2[5] = bf_hi(b.z); x2[6] = bf_lo(b.w); x2[7] = bf_hi(b.w);
            float ss = 0.f;
#pragma unroll
            for (int j = 0; j < 8; ++j) ss += x1[j] * x1[j] + x2[j] * x2[j];
            ss += shx(ss, lane, 16); ss += shx(ss, lane, 32);
            const float rs = rsqrtf(ss * (1.f / 64.f) + EPS_) * qscale;
            float o1[8], o2[8];
#pragma unroll
            for (int j = 0; j < 8; ++j) { const float c = COS[t * 32 + fq * 8 + j], s = SIN[t * 32 + fq * 8 + j];
                const float y1 = x1[j] * rs * p.qg[fq * 8 + j], y2 = x2[j] * rs * p.qg[32 + fq * 8 + j];
                o1[j] = y1 * c - y2 * s; o2[j] = y2 * c + y1 * s; }
            u32x4 w1, w2;
            w1.x = pk_bf16(o1[0], o1[1]); w1.y = pk_bf16(o1[2], o1[3]); w1.z = pk_bf16(o1[4], o1[5]); w1.w = pk_bf16(o1[6], o1[7]);
            w2.x = pk_bf16(o2[0], o2[1]); w2.y = pk_bf16(o2[2], o2[3]); w2.z = pk_bf16(o2[4], o2[5]); w2.w = pk_bf16(o2[6], o2[7]);
            qf[mt][0] = __builtin_bit_cast(bf16x8, w1); qf[mt][1] = __builtin_bit_cast(bf16x8, w2); }
        f32x4 sacc[10][2];
#pragma unroll
        for (int n = 0; n < 10; ++n) { sacc[n][0] = (f32x4){0.f, 0.f, 0.f, 0.f}; sacc[n][1] = (f32x4){0.f, 0.f, 0.f, 0.f}; }
#pragma unroll
        for (int n = 0; n < 10; ++n) { const int nt = 2 * half + n;
#pragma unroll
            for (int ks = 0; ks < 2; ++ks) { const bf16x8 kf = *(const bf16x8*)(Ks + (nt * 16 + fr) * 72 + ks * 32 + fq * 8);
                sacc[n][0] = mfma16(kf, qf[0][ks], sacc[n][0]); sacc[n][1] = mfma16(kf, qf[1][ks], sacc[n][1]); } }
        __builtin_amdgcn_sched_barrier(0);
        float lsum[2] = {0.f, 0.f};
        u32x2 pw[10][2];
#pragma unroll
        for (int n = 0; n < 10; ++n) { const int nt = 2 * half + n;
#pragma unroll
            for (int mt = 0; mt < 2; ++mt) { const int t = tw0 + mt * 16 + fr; float pv[4];
#pragma unroll
                for (int j = 0; j < 4; ++j) { const int s = t0 - 128 + nt * 16 + fq * 4 + j, df = t - s;
                    const bool ok = (df >= 0) && (df < 128) && (s >= 0);
                    pv[j] = ok ? __builtin_amdgcn_exp2f(sacc[n][mt][j] - mb) : 0.f; lsum[mt] += pv[j]; }
                pw[n][mt].x = pk_bf16(pv[0], pv[1]); pw[n][mt].y = pk_bf16(pv[2], pv[3]); } }
        f32x4 oacc[4][2];
#pragma unroll
        for (int d = 0; d < 4; ++d) { oacc[d][0] = (f32x4){0.f, 0.f, 0.f, 0.f}; oacc[d][1] = (f32x4){0.f, 0.f, 0.f, 0.f}; }
#pragma unroll
        for (int kk = 0; kk < 5; ++kk) { __builtin_amdgcn_sched_barrier(0); const int nta = 2 * half + 2 * kk;
            u32x4 b0, b1; b0.x = pw[2 * kk][0].x; b0.y = pw[2 * kk][0].y; b0.z = pw[2 * kk + 1][0].x; b0.w = pw[2 * kk + 1][0].y;
            b1.x = pw[2 * kk][1].x; b1.y = pw[2 * kk][1].y; b1.z = pw[2 * kk + 1][1].x; b1.w = pw[2 * kk + 1][1].y;
            const bf16x8 pf0 = __builtin_bit_cast(bf16x8, b0), pf1 = __builtin_bit_cast(bf16x8, b1);
#pragma unroll
            for (int d = 0; d < 4; ++d) { const u16* vp = Vt + (d * 16 + fr) * VSTR + nta * 16 + fq * 4;
                const u32x2 va = *(const u32x2*)vp, vb = *(const u32x2*)(vp + 16);
                u32x4 vv; vv.x = va.x; vv.y = va.y; vv.z = vb.x; vv.w = vb.y; const bf16x8 vf = __builtin_bit_cast(bf16x8, vv);
                oacc[d][0] = mfma16(vf, pf0, oacc[d][0]); oacc[d][1] = mfma16(vf, pf1, oacc[d][1]); } }
        const float sk = __builtin_amdgcn_exp2f(sinkv * LOG2E - mb);
        u16* BOA = (u16*)((unsigned char*)p.out + 67108864);
#pragma unroll
        for (int mt = 0; mt < 2; ++mt) { float l = lsum[mt]; l += shx(l, lane, 16); l += shx(l, lane, 32); l += sk;
            const float inv = 1.f / l; const int t = tw0 + mt * 16 + fr;
#pragma unroll
            for (int d = 0; d < 4; ++d) { u32x2 w; w.x = pk_bf16(oacc[d][mt][0] * inv, oacc[d][mt][1] * inv); w.y = pk_bf16(oacc[d][mt][2] * inv, oacc[d][mt][3] * inv);
                *(u32x2*)(BOA + (size_t)t * 2048 + head * 64 + d * 16 + fq * 4) = w; } }
    }
    __syncthreads();
}

__device__ __forceinline__ void mem_item(const Params& p, int item, unsigned char* lds, float mbound_nat, const int tid_in) {
    int zi = 0; asm volatile("" : "+v"(zi)); const int tid = tid_in + zi;
    const u16* __restrict__ proj = (const u16*)(p.ws + WS_PROJ);
    const u16* __restrict__ MKV = (const u16*)(p.ws + WS_MEMKV);
    u16* Ks = (u16*)lds;
    u16* Vt = (u16*)(lds + 69632);
    const int tt = item >> 2, h = item & 3, t0 = tt * 128;
    const int lane = tid & 63, wave = tid >> 6, fr = lane & 15, fq = lane >> 4;
#pragma unroll
    for (int ps = 0; ps < 8; ++ps) { const int idx = ps * NTHR + tid, key = idx >> 4, l16 = idx & 15;
        const u32x4 a = *(const u32x4*)(MKV + (size_t)key * 1024 + h * 128 + l16 * 8);
        float x[8]; x[0] = bf_lo(a.x); x[1] = bf_hi(a.x); x[2] = bf_lo(a.y); x[3] = bf_hi(a.y); x[4] = bf_lo(a.z); x[5] = bf_hi(a.z); x[6] = bf_lo(a.w); x[7] = bf_hi(a.w);
        float ss = 0.f;
#pragma unroll
        for (int j = 0; j < 8; ++j) ss += x[j] * x[j];
        ss = row_sum16(ss);
        const float rs = rsqrtf(ss * (1.f / 128.f) + EPS_);
        const f32x4 g1 = *(const f32x4*)(p.mkg + l16 * 8), g2 = *(const f32x4*)(p.mkg + l16 * 8 + 4);
        u32x4 w; w.x = pk_bf16(x[0] * rs * g1[0], x[1] * rs * g1[1]); w.y = pk_bf16(x[2] * rs * g1[2], x[3] * rs * g1[3]);
        w.z = pk_bf16(x[4] * rs * g2[0], x[5] * rs * g2[1]); w.w = pk_bf16(x[6] * rs * g2[2], x[7] * rs * g2[3]);
        *(u32x4*)(Ks + key * 136 + l16 * 8) = w;
        const int L = ps * NTHR + tid, kblk = L >> 6, vkey = (kblk & 15) * 16 + (L & 15), vc = (kblk >> 4) * 4 + ((L >> 4) & 3);
        const u32x4 v = *(const u32x4*)(MKV + (size_t)vkey * 1024 + 512 + h * 128 + vc * 8);
        u16* vp = Vt + (vc * 8) * 264 + vkey;
        vp[0] = (u16)v.x; vp[264] = (u16)(v.x >> 16); vp[528] = (u16)v.y; vp[792] = (u16)(v.y >> 16);
        vp[1056] = (u16)v.z; vp[1320] = (u16)(v.z >> 16); vp[1584] = (u16)v.w; vp[1848] = (u16)(v.w >> 16); }
    __syncthreads();
    {
        const float mb = mbound_nat * LOG2E;
        const float qscale = 0.08838834764831845f * LOG2E;
        const int t = t0 + wave * 16 + fr;
        bf16x8 qf[4];
        { u32x4 a[4]; float ss = 0.f;
#pragma unroll
            for (int ks = 0; ks < 4; ++ks) { a[ks] = *(const u32x4*)(proj + (size_t)t * INW + C_MQ + h * 128 + ks * 32 + fq * 8);
                const float x0 = bf_lo(a[ks].x), x1 = bf_hi(a[ks].x), x2 = bf_lo(a[ks].y), x3 = bf_hi(a[ks].y), x4 = bf_lo(a[ks].z), x5 = bf_hi(a[ks].z), x6 = bf_lo(a[ks].w), x7 = bf_hi(a[ks].w);
                ss += x0 * x0 + x1 * x1 + x2 * x2 + x3 * x3 + x4 * x4 + x5 * x5 + x6 * x6 + x7 * x7; }
            ss += shx(ss, lane, 16); ss += shx(ss, lane, 32);
            const float rs = rsqrtf(ss * (1.f / 128.f) + EPS_) * qscale;
#pragma unroll
            for (int ks = 0; ks < 4; ++ks) { const float* gp = p.mqg + ks * 32 + fq * 8; u32x4 w;
                w.x = pk_bf16(bf_lo(a[ks].x) * rs * gp[0], bf_hi(a[ks].x) * rs * gp[1]); w.y = pk_bf16(bf_lo(a[ks].y) * rs * gp[2], bf_hi(a[ks].y) * rs * gp[3]);
                w.z = pk_bf16(bf_lo(a[ks].z) * rs * gp[4], bf_hi(a[ks].z) * rs * gp[5]); w.w = pk_bf16(bf_lo(a[ks].w) * rs * gp[6], bf_hi(a[ks].w) * rs * gp[7]);
                qf[ks] = __builtin_bit_cast(bf16x8, w); } }
        f32x4 sacc[16];
#pragma unroll
        for (int n = 0; n < 16; ++n) sacc[n] = (f32x4){0.f, 0.f, 0.f, 0.f};
#pragma unroll
        for (int n = 0; n < 16; ++n)
#pragma unroll
            for (int ks = 0; ks < 4; ++ks) { const bf16x8 kf = *(const bf16x8*)(Ks + (n * 16 + fr) * 136 + ks * 32 + fq * 8); sacc[n] = mfma16(kf, qf[ks], sacc[n]); }
        __builtin_amdgcn_sched_barrier(0);
        float lsum = 0.f; u32x2 pw[16];
#pragma unroll
        for (int n = 0; n < 16; ++n) { float pv[4];
#pragma unroll
            for (int j = 0; j < 4; ++j) { pv[j] = __builtin_amdgcn_exp2f(sacc[n][j] - mb); lsum += pv[j]; }
            pw[n].x = pk_bf16(pv[0], pv[1]); pw[n].y = pk_bf16(pv[2], pv[3]); }
        f32x4 oacc[8];
#pragma unroll
        for (int d = 0; d < 8; ++d) oacc[d] = (f32x4){0.f, 0.f, 0.f, 0.f};
#pragma unroll
        for (int kk = 0; kk < 8; ++kk) { __builtin_amdgcn_sched_barrier(0); u32x4 b; b.x = pw[2 * kk].x; b.y = pw[2 * kk].y; b.z = pw[2 * kk + 1].x; b.w = pw[2 * kk + 1].y;
            const bf16x8 pf = __builtin_bit_cast(bf16x8, b);
#pragma unroll
            for (int d = 0; d < 8; ++d) { const u16* vp = Vt + (d * 16 + fr) * 264 + kk * 32 + fq * 4;
                const u32x2 va = *(const u32x2*)vp, vb = *(const u32x2*)(vp + 16);
                u32x4 vv; vv.x = va.x; vv.y = va.y; vv.z = vb.x; vv.w = vb.y;
                oacc[d] = mfma16(__builtin_bit_cast(bf16x8, vv), pf, oacc[d]); } }
        lsum += shx(lsum, lane, 16); lsum += shx(lsum, lane, 32);
        const float inv = 1.f / lsum;
        u16* BOM = (u16*)((unsigned char*)p.out + 67108864) + 1536;
#pragma unroll
        for (int d = 0; d < 8; ++d) { u32x2 w; w.x = pk_bf16(oacc[d][0] * inv, oacc[d][1] * inv); w.y = pk_bf16(oacc[d][2] * inv, oacc[d][3] * inv);
            *(u32x2*)(BOM + (size_t)t * 2048 + h * 128 + d * 16 + fq * 4) = w; }
    }
    __syncthreads();
}

__device__ __forceinline__ void conv_item(const Params& p, int item, unsigned char* lds, const int tid_in) {
    int zi = 0; asm volatile("" : "+v"(zi)); const int tid = tid_in + zi;
    const u16* __restrict__ proj = (const u16*)(p.ws + WS_PROJ);
    float* G = (float*)lds;
    float* red = (float*)(lds + 126976);
    const int lane = tid & 63, wave = tid >> 6;
    const int t0 = item * 32;
    { const int c8 = (tid & 63) * 8, rr = tid >> 6;
        u32x4 av[8], bv[8];
#pragma unroll
        for (int ps = 0; ps < 8; ++ps) { const int r = ps * 8 + rr; int t = t0 - 30 + r; t = t < 0 ? 0 : (t > S_ - 1 ? S_ - 1 : t);
            av[ps] = *(const u32x4*)(proj + (size_t)t * INW + C_CA + c8); bv[ps] = *(const u32x4*)(proj + (size_t)t * INW + C_CB + c8); }
#pragma unroll
        for (int ps = 0; ps < 8; ++ps) { const int r = ps * 8 + rr, t = t0 - 30 + r;
            if (r < 62) { const bool ok = t >= 0; f32x4 g0, g1;
                g0[0] = ok ? bf_lo(av[ps].x) * fast_sigmoid(bf_lo(bv[ps].x)) : 0.f; g0[1] = ok ? bf_hi(av[ps].x) * fast_sigmoid(bf_hi(bv[ps].x)) : 0.f;
                g0[2] = ok ? bf_lo(av[ps].y) * fast_sigmoid(bf_lo(bv[ps].y)) : 0.f; g0[3] = ok ? bf_hi(av[ps].y) * fast_sigmoid(bf_hi(bv[ps].y)) : 0.f;
                g1[0] = ok ? bf_lo(av[ps].z) * fast_sigmoid(bf_lo(bv[ps].z)) : 0.f; g1[1] = ok ? bf_hi(av[ps].z) * fast_sigmoid(bf_hi(bv[ps].z)) : 0.f;
                g1[2] = ok ? bf_lo(av[ps].w) * fast_sigmoid(bf_lo(bv[ps].w)) : 0.f; g1[3] = ok ? bf_hi(av[ps].w) * fast_sigmoid(bf_hi(bv[ps].w)) : 0.f;
                *(f32x4*)(G + r * 512 + c8) = g0; *(f32x4*)(G + r * 512 + c8 + 4) = g1; } } }
    __syncthreads();
    const int ch = tid;
    const float bias = p.dw_b[ch];
    float wgt[31];
#pragma unroll
    for (int j = 0; j < 31; ++j) wgt[j] = p.dw_w[j * 512 + ch];
#pragma unroll 1
    for (int sub = 0; sub < 4; ++sub) { const int base = sub * 8;
        float g[38];
#pragma unroll
        for (int r = 0; r < 38; ++r) g[r] = G[(base + r) * 512 + ch];
        float ac[8];
#pragma unroll
        for (int o = 0; o < 8; ++o) ac[o] = bias;
#pragma unroll
        for (int j = 0; j < 31; ++j) {
#pragma unroll
            for (int o = 0; o < 8; ++o) ac[o] += wgt[j] * g[o + j]; }
#pragma unroll
        for (int o = 0; o < 8; ++o) G[(base + o) * 512 + ch] = ac[o]; }
    __syncthreads();
#pragma unroll
    for (int i = 0; i < 4; ++i) { const int row = wave * 4 + i; float sm = 0.f, sq = 0.f;
#pragma unroll
        for (int j = 0; j < 8; ++j) { const float v = G[row * 512 + j * 64 + lane]; sm += v; sq += v * v; }
        sm = wave_sum(sm); sq = wave_sum(sq);
        if (lane == 0) { red[512 + row] = sm; red[512 + 32 + row] = sq; } }
    __syncthreads();
    const float lg = p.ln_g[ch], lb = p.ln_b[ch];
    u16* BOC = (u16*)((unsigned char*)p.out + 67108864) + 1024;
#pragma unroll
    for (int k = 0; k < 32; ++k) { const float s = red[512 + k], q = red[512 + 32 + k];
        const float mu = s * (1.f / 512.f), var = fmaxf(q * (1.f / 512.f) - mu * mu, 0.f), rstd = rsqrtf(var + EPS_);
        const float y = (G[k * 512 + ch] - mu) * rstd * lg + lb;
        const u32 w = pk_bf16(y * fast_sigmoid(y), 0.f);
        BOC[(size_t)(t0 + k) * 2048 + ch] = (u16)w; }
    __syncthreads();
}

__device__ __forceinline__ void phase_mix(const Params& p, unsigned char* lds) {
    float mq = 0.f, mk = 0.f, mmq = 0.f, mmk = 0.f;
    for (int i = 0; i < 64; ++i) { mq = fmaxf(mq, fabsf(p.qg[i])); mk = fmaxf(mk, fabsf(p.kg[i])); }
    for (int i = 0; i < 128; ++i) { mmq = fmaxf(mmq, fabsf(p.mqg[i])); mmk = fmaxf(mmk, fabsf(p.mkg[i])); }
    const float swa_bound = 8.f * mq * mk * 1.02f + 0.1f, mem_bound = 11.313708498984761f * mmq * mmk * 1.02f + 0.1f;
    if (MIX_MASK & 1) { int z = 0; asm volatile("" : "+v"(z)); const int tz = threadIdx.x + z;
#define SWA_ITEM(v) (((((v) & 7) * 32 + (((v) >> 3) & 31)) << 2) | ((v) >> 8))
        SwaPre pre; if ((int)blockIdx.x < 1024) swa_preload(p, SWA_ITEM((int)blockIdx.x), tz, pre);
        for (int it = blockIdx.x; it < 1024; it += gridDim.x) { const int nx = it + (int)gridDim.x; swa_item(p, SWA_ITEM(it), lds, swa_bound, tz, pre, nx < 1024 ? SWA_ITEM(nx) : -1); } }
    if (MIX_MASK & 2) { int z = 0; asm volatile("" : "+v"(z)); const int tz = threadIdx.x + z; for (int it = blockIdx.x; it < 512; it += gridDim.x) mem_item(p, ((((it & 7) * 16 + (it >> 5)) << 2) | ((it >> 3) & 3)), lds, mem_bound, tz); }
    if (MIX_MASK & 4) { int z = 0; asm volatile("" : "+v"(z)); const int tz = threadIdx.x + z; for (int rep = 0; rep < ((MIXDUP & 4) ? 2 : 1); ++rep) for (int it = blockIdx.x; it < 512; it += gridDim.x) conv_item(p, ((it & 7) << 6) | (it >> 3), lds, tz); }
}

__device__ __forceinline__ void phase_h2(const Params& p) {
    const int tid = threadIdx.x, lane = tid & 63, wave = tid >> 6;
    { const int nw = gridDim.x * 8, w0 = blockIdx.x * 8 + wave;
        for (int r = w0; r < S_; r += 4 * nw) {
            if (r + 3 * nw < S_) rms_rows<4>(p.out + (size_t)r * D_, p.g_ffn, (u16*)(p.ws + WS_MERGED) + (size_t)r * D_, (size_t)nw * D_, lane);
            else for (int q = r; q < S_; q += nw) rms_rows<1>(p.out + (size_t)q * D_, p.g_ffn, (u16*)(p.ws + WS_MERGED) + (size_t)q * D_, 0, lane); } }
}

__device__ __forceinline__ void convert_experts(const Params& p, const int part) {
    int zc = 0; asm volatile("" : "+v"(zc)); const int tid = (int)threadIdx.x + zc, lane = tid & 63, wave = tid >> 6;
    for (int rr = part * 8192 + blockIdx.x * 8 + wave; rr < (part + 1) * 8192; rr += gridDim.x * 8) {
        f32x4 v[2][8]; float mx[2] = {0.f, 0.f};
#pragma unroll
        for (int q = 0; q < 2; ++q) { const float* src = (q ? p.ev : p.eu) + (size_t)rr * 2048 + lane * 32;
#pragma unroll
            for (int k = 0; k < 8; ++k) v[q][k] = *(const f32x4*)(src + k * 4); }
#pragma unroll
        for (int q = 0; q < 2; ++q) {
#pragma unroll
            for (int k = 0; k < 8; ++k) mx[q] = fmaxf(mx[q], fmaxf(fmaxf(fabsf(v[q][k][0]), fabsf(v[q][k][1])), fmaxf(fabsf(v[q][k][2]), fabsf(v[q][k][3]))));
            mx[q] = wave_max(mx[q]);
            const u32 mb = __float_as_uint(mx[q]); int eb = (int)((mb >> 23) & 255u); eb = eb < 8 ? 8 : (eb > 250 ? 250 : eb);
            const bool small = (mb & 0x7fffffu) <= 0x700000u;
            const float sc = __uint_as_float((u32)((small ? 256 : 255) - eb) << 23), inv = __uint_as_float((u32)(eb - (small ? 2 : 1)) << 23);
            v16f xa, xb;
#pragma unroll
            for (int i = 0; i < 16; ++i) { xa[i] = v[q][(2 * i) >> 2][(2 * i) & 3] * sc; xb[i] = v[q][(2 * i + 1) >> 2][(2 * i + 1) & 3] * sc; }
            const v6u qq = __builtin_amdgcn_cvt_scalef32_2xpk16_fp6_f32(xa, xb, 1.0f);
            unsigned char* dst = p.ws + WS_EU + (size_t)rr * 3072 + (q ? 1536 : 0);
            *(u32x4*)(dst + lane * 16) = (u32x4){qq[0], qq[1], qq[2], qq[3]};
            *(u32x2*)(dst + 1024 + lane * 8) = (u32x2){qq[4], qq[5]};
            if (lane == 0) ((float*)(p.ws + (q ? WS_SVI : WS_SUI)))[rr] = inv; } }
}

constexpr unsigned char CAND_I[64] = {0,0,0,0,0,0,0,0,0,0,0,0,0,0,0,0,1,1,1,1,1,1,1,1,2,2,2,2,2,3,3,3,3,4,4,4,5,5,6,6,7,7,8,9,10,11,12,13,14,15,255,255,255,255,255,255,255,255,255,255,255,255,255,255};
constexpr unsigned char CAND_J[64] = {0,1,2,3,4,5,6,7,8,9,10,11,12,13,14,15,0,1,2,3,4,5,6,7,0,1,2,3,4,0,1,2,3,0,1,2,0,1,0,1,0,1,0,0,0,0,0,0,0,0,255,255,255,255,255,255,255,255,255,255,255,255,255,255};
__device__ __forceinline__ void sort16_desc(u32 (&a)[16]) {
#pragma unroll
    for (int k = 2; k <= 16; k <<= 1)
#pragma unroll
        for (int j = k >> 1; j > 0; j >>= 1)
#pragma unroll
            for (int i = 0; i < 16; ++i) { const int l = i ^ j;
                if (l > i) { const bool desc = ((i & k) == 0); const u32 hi = max(a[i], a[l]), lo = min(a[i], a[l]); a[i] = desc ? hi : lo; a[l] = desc ? lo : hi; } }
}
__device__ __forceinline__ void merge16_desc(u32 (&R)[16], const u32 (&G)[16]) {
#pragma unroll
    for (int i = 0; i < 16; ++i) R[i] = max(R[i], G[15 - i]);
#pragma unroll
    for (int j = 8; j > 0; j >>= 1)
#pragma unroll
        for (int i = 0; i < 16; ++i) { const int l = i ^ j; if (l > i) { const u32 hi = max(R[i], R[l]), lo = min(R[i], R[l]); R[i] = hi; R[l] = lo; } }
}
__device__ __forceinline__ void topk_rows(const Params& p, unsigned char* lds, const int tok0, const int lgn, const int hbase, const int tid_in) {
    int zi = 0; asm volatile("" : "+v"(zi)); const int tid = tid_in + zi;
    float* sc = (float*)lds;
    float* tv = (float*)lds;
    int* ti = (int*)(lds + 17408);
    const u16* __restrict__ Q = (const u16*)(p.ws + WS_Q); const u16* __restrict__ SK = (const u16*)(p.ws + WS_SK);
    const int nmask = (1 << lgn) - 1;
    const int lane = tid & 63, wave = tid >> 6, fr = lane & 15, fq = lane >> 4;
    {
        const int side = wave & 1, quarter = wave >> 1;
        bf16x8 af[2][4]; int hd[2];
#pragma unroll
        for (int mt = 0; mt < 2; ++mt) { const int rho0 = quarter * 32 + mt * 16; hd[mt] = hbase + (rho0 >> lgn);
#pragma unroll
            for (int ks = 0; ks < 4; ++ks) af[mt][ks] = *(const bf16x8*)(Q + (size_t)(tok0 + ((rho0 + fr) & nmask)) * 2048 + hd[mt] * 256 + side * 128 + ks * 32 + fq * 8); }
        f32x4 acc[2][8];
#pragma unroll
        for (int nt = 0; nt < 8; ++nt) { acc[0][nt] = (f32x4){0.f, 0.f, 0.f, 0.f}; acc[1][nt] = (f32x4){0.f, 0.f, 0.f, 0.f}; }
#pragma unroll
        for (int mt = 0; mt < 2; ++mt)
#pragma unroll
            for (int nt = 0; nt < 8; ++nt)
#pragma unroll
                for (int ks = 0; ks < 4; ++ks) { const bf16x8 b = *(const bf16x8*)(SK + (size_t)((hd[mt] * 2 + side) * 128 + nt * 16 + fr) * 128 + ks * 32 + fq * 8);
                    acc[mt][nt] = mfma16(af[mt][ks], b, acc[mt][nt]); }
#pragma unroll
        for (int mt = 0; mt < 2; ++mt)
#pragma unroll
            for (int nt = 0; nt < 8; ++nt)
#pragma unroll
                for (int j = 0; j < 4; ++j) sc[(side * 128 + quarter * 32 + mt * 16 + fq * 4 + j) * 129 + nt * 16 + fr] = acc[mt][nt][j];
    }
    __syncthreads();
    u32 v[16]; float val[16]; const int tok = tid & 127, sd = (tid >> 7) & 1, half = tid >> 8;
    u32* kbuf = (u32*)(lds + 132096);
    const float* row = sc + (sd * 128 + tok) * 129;
#pragma unroll
    for (int k = 0; k < 16; ++k) { v[k] = 0u; val[k] = 0.f; }
#pragma unroll
    for (int grp = 0; grp < 4; ++grp) { u32 gk[16];
#pragma unroll
        for (int i = 0; i < 16; ++i) { const int n = half * 64 + grp * 16 + i; gk[i] = (mono_key(row[n]) & ~127u) | (u32)(127 - n); }
        sort16_desc(gk);
        if (grp == 0) {
#pragma unroll
            for (int i = 0; i < 16; ++i) v[i] = gk[i]; }
        else merge16_desc(v, gk); }
    if (half) {
#pragma unroll
        for (int k = 0; k < 16; ++k) kbuf[(sd * 128 + tok) * 17 + k] = v[k]; }
    __syncthreads();
    if (!half) { u32 gk[16];
#pragma unroll
        for (int i = 0; i < 16; ++i) gk[i] = kbuf[(sd * 128 + tok) * 17 + i];
        merge16_desc(v, gk);
#pragma unroll
        for (int k = 0; k < 16; ++k) val[k] = row[127 - (int)(v[k] & 127u)]; }
    __syncthreads();
    if (!half) {
#pragma unroll
        for (int k = 0; k < 16; ++k) { tv[(sd * 128 + tok) * 17 + k] = val[k]; ti[(sd * 128 + tok) * 17 + k] = 127 - (int)(v[k] & 127u); } }
    __syncthreads();
    if (tid < 128) { float v1[16], v2[16];
#pragma unroll
        for (int k = 0; k < 16; ++k) { v1[k] = tv[tid * 17 + k]; v2[k] = tv[(128 + tid) * 17 + k]; }
        u32 w[16];
#pragma unroll
        for (int grp = 0; grp < 4; ++grp) { u32 gk[16];
#pragma unroll
            for (int i = 0; i < 16; ++i) { const int c = grp * 16 + i;
                gk[i] = (CAND_I[c] < 16) ? ((mono_key(v1[CAND_I[c] & 15] + v2[CAND_J[c] & 15]) & ~255u) | (u32)(255 - ((CAND_I[c] & 15) * 16 + (CAND_J[c] & 15)))) : 0u; }
            sort16_desc(gk);
            if (grp == 0) {
#pragma unroll
                for (int i = 0; i < 16; ++i) w[i] = gk[i]; }
            else merge16_desc(w, gk); }
        float s[16]; int eid[16]; float m = -3.0e38f;
#pragma unroll
        for (int k = 0; k < 16; ++k) { const int cid = 255 - (int)(w[k] & 255u), i = cid >> 4, j = cid & 15;
            s[k] = tv[tid * 17 + i] + tv[(128 + tid) * 17 + j]; eid[k] = ti[tid * 17 + i] * 128 + ti[(128 + tid) * 17 + j]; m = fmaxf(m, s[k]); }
        float sum = 0.f;
#pragma unroll
        for (int k = 0; k < 16; ++k) { s[k] = __expf(s[k] - m); sum += s[k]; }
        const float inv = 1.f / sum;
        const size_t so = (size_t)(tok0 + (tid & nmask)) * 128 + (hbase + (tid >> lgn)) * 16;
        int* SI = (int*)(p.ws + WS_SI) + so; float* SG = (float*)(p.ws + WS_SG) + so;
        float* SGU = (float*)(p.ws + WS_SGU) + so; const float* SUI = (const float*)(p.ws + WS_SUI); const float* SVI = (const float*)(p.ws + WS_SVI);
        float svi[16], sui[16];
#pragma unroll
        for (int k = 0; k < 16; ++k) { svi[k] = SVI[eid[k]]; sui[k] = SUI[eid[k]]; }
#pragma unroll
        for (int k = 0; k < 16; k += 4) { *(int4*)(SI + k) = make_int4(eid[k], eid[k + 1], eid[k + 2], eid[k + 3]);
            *(f32x4*)(SG + k) = (f32x4){s[k] * inv * svi[k], s[k + 1] * inv * svi[k + 1], s[k + 2] * inv * svi[k + 2], s[k + 3] * inv * svi[k + 3]};
            *(f32x4*)(SGU + k) = (f32x4){sui[k], sui[k + 1], sui[k + 2], sui[k + 3]}; } }
    __syncthreads();
}

__device__ __forceinline__ void peer_token(const Params& p, const int tok, const int lane) {
    const u16* __restrict__ H2 = (const u16*)(p.ws + WS_MERGED);
    const unsigned char* __restrict__ EU = p.ws + WS_EU; const unsigned char* __restrict__ EV = p.ws + WS_EV;
    const int* __restrict__ SI = (const int*)(p.ws + WS_SI); const float* __restrict__ SG = (const float*)(p.ws + WS_SG); const float* __restrict__ SGU = (const float*)(p.ws + WS_SGU);
    {
        f32x2 h[16];
#pragma unroll
        for (int c = 0; c < 4; ++c) { const u32x4 a = *(const u32x4*)(H2 + (size_t)tok * 2048 + lane * 32 + c * 8);
            h[c * 4 + 0] = (f32x2){bf_lo(a.x), bf_hi(a.x)}; h[c * 4 + 1] = (f32x2){bf_lo(a.y), bf_hi(a.y)}; h[c * 4 + 2] = (f32x2){bf_lo(a.z), bf_hi(a.z)}; h[c * 4 + 3] = (f32x2){bf_lo(a.w), bf_hi(a.w)}; }
        const int i0 = SI[(size_t)tok * 128 + lane], i1 = SI[(size_t)tok * 128 + 64 + lane];
        const float g0 = SG[(size_t)tok * 128 + lane], g1 = SG[(size_t)tok * 128 + 64 + lane];
        const float r0 = SGU[(size_t)tok * 128 + lane], r1 = SGU[(size_t)tok * 128 + 64 + lane];
        f32x2 y[16];
#pragma unroll
        for (int k = 0; k < 16; ++k) y[k] = (f32x2){0.f, 0.f};
        u32x4 uA, vA, uB, vB, uC, vC, uD, vD, uE, vE, uF, vF; u32x2 uA2, vA2, uB2, vB2, uC2, vC2, uD2, vD2, uE2, vE2, uF2, vF2;
#define PEER_LOAD(e, U, V) do { const int _e = (e); const int _id = __builtin_amdgcn_readlane(_e < 64 ? i0 : i1, _e & 63); \
            const unsigned char* _pu = EU + (size_t)_id * 3072; const unsigned char* _pv = _pu + 1536; \
            U = *(const u32x4*)(_pu + lane * 16); U##2 = *(const u32x2*)(_pu + 1024 + lane * 8); V = *(const u32x4*)(_pv + lane * 16); V##2 = *(const u32x2*)(_pv + 1024 + lane * 8); } while (0)
#define PEER_COMP(e, U, V) do { const int _e = (e); f32x2 a0 = (f32x2){0.f, 0.f}, a1 = (f32x2){0.f, 0.f}; \
            { const v32f uf = __builtin_amdgcn_cvt_scalef32_pk32_f32_fp6((v6u){U.x, U.y, U.z, U.w, (U##2).x, (U##2).y}, 1.0f); \
            _Pragma("unroll") for (int k = 0; k < 16; k += 2) { a0 = __builtin_elementwise_fma((f32x2){uf[2 * k], uf[2 * k + 1]}, h[k], a0); a1 = __builtin_elementwise_fma((f32x2){uf[2 * k + 2], uf[2 * k + 3]}, h[k + 1], a1); } } \
            const float a = wave_sum((a0.x + a0.y) + (a1.x + a1.y)) * rdlane(_e < 64 ? r0 : r1, _e & 63); const float gt_ = rdlane(_e < 64 ? g0 : g1, _e & 63); \
            const float act = 0.5f * a * (1.f + erff(a * 0.70710678118654752f)) * gt_; const f32x2 act2 = (f32x2){act, act}; \
            { const v32f vf = __builtin_amdgcn_cvt_scalef32_pk32_f32_fp6((v6u){V.x, V.y, V.z, V.w, (V##2).x, (V##2).y}, 1.0f); \
            _Pragma("unroll") for (int k = 0; k < 16; ++k) y[k] = __builtin_elementwise_fma((f32x2){vf[2 * k], vf[2 * k + 1]}, act2, y[k]); } } while (0)
        PEER_LOAD(0, uA, vA); PEER_LOAD(1, uB, vB); PEER_LOAD(2, uC, vC); PEER_LOAD(3, uD, vD); PEER_LOAD(4, uE, vE);
        for (int e = 0; e < 126; e += 6) {
            PEER_LOAD(e + 5, uF, vF);
            PEER_COMP(e, uA, vA);
            PEER_LOAD(e + 6, uA, vA);
            PEER_COMP(e + 1, uB, vB);
            PEER_LOAD(e + 7, uB, vB);
            PEER_COMP(e + 2, uC, vC);
            if (e + 8 < 128) PEER_LOAD(e + 8, uC, vC);
            PEER_COMP(e + 3, uD, vD);
            if (e + 8 < 128) PEER_LOAD(e + 9, uD, vD);
            PEER_COMP(e + 4, uE, vE);
            if (e + 8 < 128) PEER_LOAD(e + 10, uE, vE);
            PEER_COMP(e + 5, uF, vF);
        }
        PEER_COMP(126, uA, vA); PEER_COMP(127, uB, vB);
#undef PEER_LOAD
#undef PEER_COMP
        float* op = p.out + (size_t)tok * 2048 + lane * 32; f32x4 xo[8];
#pragma unroll
        for (int k = 0; k < 8; ++k) xo[k] = *(const f32x4*)(op + k * 4);
#pragma unroll
        for (int k = 0; k < 8; ++k) { f32x4 a = xo[k];
            a[0] += y[2 * k].x; a[1] += y[2 * k].y; a[2] += y[2 * k + 1].x; a[3] += y[2 * k + 1].y;
            *(f32x4*)(op + k * 4) = a; }
    }
}


__device__ __forceinline__ void phase_topk_peer(const Params& p, unsigned char* lds) {
    for (int tb = blockIdx.x; tb < S_ / 64; tb += gridDim.x) {
        const int pat = ((blockIdx.x >> 3) & 1) ? 1 : 2;
        const int code = pat == 1 ? 0x4310 : 0x420, nb = (pat & 1) ? 3 : 2;
#pragma unroll 1
        for (int bi = 0; bi < nb; ++bi) {
            const int u0 = (code >> (4 * bi)) & 15, u1 = (code >> (4 * bi + 4)) & 15, t0 = tb * 64 + u0 * 16, ntok = (u1 - u0) * 16;
#pragma unroll 1
            for (int u = u0; u < u1; ++u) topk_rows(p, lds, tb * 64 + u * 16, 4, 0, (int)threadIdx.x);
            __syncthreads();
            { int z = 0; asm volatile("" : "+v"(z)); const int tz = (int)threadIdx.x + z; const int lane = tz & 63, wave = __builtin_amdgcn_readfirstlane(tz >> 6), per = ntok >> 3;
#pragma unroll 1
                for (int i = 0; i < per; ++i) peer_token(p, t0 + wave * per + i, lane); }
        }
    }
}

constexpr int N_PHASES = 8;
#ifndef DUPMASK
#define DUPMASK 0
#endif
#ifndef PH_MASK
#define PH_MASK 0x1ff
#endif

__device__ __forceinline__ void late_transposes(const Params& p, unsigned char* lds) {
    float* T = (float*)lds; unsigned char* ws = p.ws;
    for (int j = blockIdx.x * 4; j < 3072; j += gridDim.x * 4) {
        if (j < 512) cvt_tr_tile4(p.w_attn_o, (u16*)(ws + WS_WA_T), 1024, 2048, j, T, 2048);
        else if (j < 768) cvt_tr_tile4(p.w_conv_o, (u16*)(ws + WS_WA_T) + 1024, 512, 2048, j - 512, T, 2048);
        else if (j < 1024) cvt_tr_tile4(p.w_mem_o, (u16*)(ws + WS_WA_T) + 1536, 512, 2048, j - 768, T, 2048);
        else if (j < 2048) cvt_tr_tile4(p.w_out, (u16*)(ws + WS_WOUT_T), 2048, 2048, j - 1024, T, 2048);
        else cvt_tr_tile4(p.w_query, (u16*)(ws + WS_WQ_T), 2048, 2048, j - 2048, T, 2048);
    }
    const int tid = threadIdx.x;
    const int gt = blockIdx.x * NTHR + tid, gn = gridDim.x * NTHR;
    for (int i = gt; i < S_ * 32; i += gn) { const int t = i >> 5, j = i & 31;
        const double invf = exp2(-(double)j * (13.287712379549449 / 32.0));
        const double ang = (double)p.pos[t] * invf;
        const double n = rint(ang * 0.15915494309189535);
        double r = fma(-n, 6.283185307179586, ang); r = fma(-n, 2.4492935982947064e-16, r);
        double s, c; sincos_d(r, s, c);
        ((float*)(ws + WS_COS))[i] = (float)c; ((float*)(ws + WS_SIN))[i] = (float)s; }
    for (int i = gt; i < 16 * 128 * 128 / 4; i += gn) { const f32x4 v = ((const f32x4*)p.sub_keys)[i]; u32x2 w; w.x = pk_bf16(v[0], v[1]); w.y = pk_bf16(v[2], v[3]); ((u32x2*)(ws + WS_SK))[i] = w; }
}

__device__ __forceinline__ void memkv_direct(const Params& p, unsigned char* lds) {
    const u16* __restrict__ A = (const u16*)(p.ws + WS_MEMN); const u16* __restrict__ B = (const u16*)(p.ws + WS_WKV_T);
    u16* O = (u16*)(p.ws + WS_MEMKV);
    float* red = (float*)lds;
    int z = 0; asm volatile("" : "+v"(z));
    const int tid = threadIdx.x + z, lane = tid & 63, wave = tid >> 6, fr = lane & 15, fq = lane >> 4, tw = wave & 3, kh = wave >> 2;
    for (int base = blockIdx.x * 4; base < 1024; base += gridDim.x * 4) {
        const int tile = base + tw, mt = tile & 15, nt = tile >> 4;
        const u16* ap = A + (size_t)(mt * 16 + fr) * 2048 + kh * 1024 + fq * 8; const u16* bp = B + (size_t)(nt * 16 + fr) * 2048 + kh * 1024 + fq * 8;
        f32x4 acc = (f32x4){0.f, 0.f, 0.f, 0.f};
#pragma unroll 8
        for (int ks = 0; ks < 32; ++ks) acc = mfma16(*(const bf16x8*)(ap + ks * 32), *(const bf16x8*)(bp + ks * 32), acc);
        if (kh) *(f32x4*)(red + (tw * 64 + lane) * 4) = acc;
        __syncthreads();
        if (!kh) { const f32x4 o = acc + *(const f32x4*)(red + (tw * 64 + lane) * 4);
#pragma unroll
            for (int j = 0; j < 4; ++j) O[(size_t)(mt * 16 + fq * 4 + j) * 1024 + nt * 16 + fr] = (u16)pk_bf16(o[j], 0.f); }
        __syncthreads();
    }
}
template <bool HOOKED> __device__ __forceinline__ void run_gemms(const Params& p, unsigned char* lds, const int j0, const int j1) {
    unsigned char* ws = p.ws;
    for (int j = j0; j < j1; ++j) {
        pg8::Gemm g; EpiU<HOOKED> E; E.mode = 0; E.O = nullptr; E.Of = nullptr; E.X = nullptr; E.G = nullptr; E.ldc = 0; E.ldg = INW; E.sig_from = 1 << 30;
        u16* proj = (u16*)(ws + WS_PROJ); u16* merged = (u16*)(ws + WS_MERGED);
        const u16* BO = (const u16*)((unsigned char*)p.out + 67108864);
        if (j == 0) { g = pg8::Gemm{(const u16*)p.out, (const u16*)(ws + WS_WIN_T), S_, INW, D_}; E.O = proj; E.ldc = INW; E.sig_from = C_GA; }
        else if (j == 1) { g = pg8::Gemm{(const u16*)(ws + WS_MEMN), (const u16*)(ws + WS_WKV_T), 256, 1024, D_}; E.O = (u16*)(ws + WS_MEMKV); E.ldc = 1024; }
        else if (j == 2) { g = pg8::Gemm{BO, (const u16*)(ws + WS_WA_T), S_, D_, D_}; E.mode = 1; E.O = merged; E.ldc = D_; E.G = proj + C_GA; }
        else if (j == 5) { g = pg8::Gemm{merged, (const u16*)(ws + WS_WOUT_T), S_, D_, D_}; E.mode = 2; E.Of = p.out; E.X = p.x; E.ldc = D_; }
        else { g = pg8::Gemm{merged, (const u16*)(ws + WS_WQ_T), S_, D_, D_}; E.O = (u16*)(ws + WS_Q); E.ldc = D_; }
        pg8::StaticOrder So; So.init(g.M, g.N, (int)gridDim.x, (int)blockIdx.x);
        pg8::gemm_phase<EpiU<HOOKED>, pg8::StaticOrder>((PG8_LAS unsigned char*)lds, g, So, E, nullptr);
        __syncthreads();
    }
}
__global__ void __launch_bounds__(NTHR, 2) hybrid_fwd(Params p) {
    extern __shared__ __attribute__((aligned(16))) unsigned char lds[];
    cg::grid_group grid = cg::this_grid();
    if (p.ph_lo < 0) grid.sync();
    volatile LAS unsigned* bst = (volatile LAS unsigned*)((LAS unsigned char*)lds + (LDS_BYTES - 16));
    if (threadIdx.x < 4) bst[threadIdx.x] = 0u;
    __syncthreads();
    XcdBarrier xbar = xcd_barrier_post((unsigned*)(p.ws + WS_BAR), bst);
#define IN(k) (p.ph_lo <= (k) && (k) < p.ph_hi)
#define SEAM(k) do { if (IN(k) && IN((k) + 1)) xcd_barrier(xbar); } while (0)
#define RUNPH(k, ...) __VA_ARGS__ SEAM(k); if (DUPMASK & (1 << (k))) { __VA_ARGS__ SEAM(k); }
    RUNPH(0, if ((PH_MASK & 1) && IN(0)) phase_prep(p, lds);)
    RUNPH(1, if ((PH_MASK & 2) && IN(1)) { const bool first = ((blockIdx.x >> 3) & 1) != 0; if (first) late_transposes(p, lds); run_gemms<false>(p, lds, 0, 1); memkv_direct(p, lds); if (!first) late_transposes(p, lds); })
    RUNPH(2, if ((PH_MASK & 4) && IN(2)) phase_mix(p, lds);)
    RUNPH(3, if ((PH_MASK & 8) && IN(3)) { const bool first = ((blockIdx.x >> 3) & 1) != 0; if (first) convert_experts(p, 0); run_gemms<true>(p, lds, 2, 3); if (!first) convert_experts(p, 0); })
    RUNPH(4, if ((PH_MASK & 16) && IN(4)) { const bool first = ((blockIdx.x >> 3) & 1) != 0; if (first) convert_experts(p, 1); run_gemms<false>(p, lds, 5, 6); if (!first) convert_experts(p, 1); })
    RUNPH(5, if ((PH_MASK & 32) && IN(5)) phase_h2(p);)
    RUNPH(6, if ((PH_MASK & 64) && IN(6)) run_gemms<false>(p, lds, 6, 7);)
    RUNPH(7, if ((PH_MASK & 128) && IN(7)) phase_topk_peer(p, lds);)
#ifdef EXTRA_SYNCS
    for (int i = 0; i < EXTRA_SYNCS; ++i) xcd_barrier(xbar);
#endif
    (void)0;
#undef IN
#undef SEAM
}

#ifndef MK_LAUNCHES
#define MK_LAUNCHES 1
#endif
extern "C" void kernel_launch(void* const* d_in, const int* in_sizes, int n_in, void* d_out, int out_size, void* d_ws, size_t ws_size, hipStream_t stream) {
    static int grid = 0;
    if (grid == 0) {
        if (n_in != 25 || out_size != S_ * D_ || ws_size < WS_TOTAL) { fprintf(stderr, "kernel_launch: unexpected shapes (n_in %d out %d ws %zu need %zu)\n", n_in, out_size, ws_size, (size_t)WS_TOTAL); grid = -1; return; }
        int dev = 0, cus = 0, per_cu = 0;
        hipGetDevice(&dev); hipDeviceGetAttribute(&cus, hipDeviceAttributeMultiprocessorCount, dev);
        if (hipFuncSetAttribute((const void*)hybrid_fwd, hipFuncAttributeMaxDynamicSharedMemorySize, LDS_BYTES) != hipSuccess) { fprintf(stderr, "kernel_launch: hipFuncSetAttribute failed\n"); grid = -1; return; }
        if (hipOccupancyMaxActiveBlocksPerMultiprocessor(&per_cu, (const void*)hybrid_fwd, NTHR, LDS_BYTES) != hipSuccess || per_cu < 1) { fprintf(stderr, "kernel_launch: occupancy query gave %d\n", per_cu); per_cu = 1; }
        (void)hipGetLastError();
        grid = cus * per_cu;
    }
    if (grid < 0) return;
    Params p{};
    p.x = (const float*)d_in[0]; p.mem = (const float*)d_in[1]; p.pos = (const int*)d_in[2]; p.g_mix = (const float*)d_in[3]; p.w_in = (const float*)d_in[4];
    p.qg = (const float*)d_in[5]; p.kg = (const float*)d_in[6]; p.sinks = (const float*)d_in[7]; p.w_attn_o = (const float*)d_in[8]; p.dw_w = (const float*)d_in[9];
    p.dw_b = (const float*)d_in[10]; p.ln_g = (const float*)d_in[11]; p.ln_b = (const float*)d_in[12]; p.w_conv_o = (const float*)d_in[13]; p.g_mem = (const float*)d_in[14];
    p.w_mem_kv = (const float*)d_in[15]; p.mqg = (const float*)d_in[16]; p.mkg = (const float*)d_in[17]; p.w_mem_o = (const float*)d_in[18]; p.w_out = (const float*)d_in[19];
    p.g_ffn = (const float*)d_in[20]; p.w_query = (const float*)d_in[21]; p.sub_keys = (const float*)d_in[22]; p.eu = (const float*)d_in[23]; p.ev = (const float*)d_in[24];
    p.out = (float*)d_out; p.ws = (unsigned char*)d_ws;
#if MK_LAUNCHES == 1
    if (hipMemsetAsync((unsigned char*)d_ws + WS_BAR, 0, 16384, stream) != hipSuccess) { fprintf(stderr, "kernel_launch: memset of the barrier words failed\n"); return; }
    p.ph_lo = 0; p.ph_hi = N_PHASES;
    void* args[] = {&p};
    hipError_t e = hipLaunchCooperativeKernel((const void*)hybrid_fwd, dim3(grid), dim3(NTHR), args, LDS_BYTES, stream);
    if (e != hipSuccess) fprintf(stderr, "kernel_launch: cooperative launch failed: %s (grid %d)\n", hipGetErrorString(e), grid);
#else
    for (int ph = 0; ph < N_PHASES; ++ph) { p.ph_lo = ph; p.ph_hi = ph + 1; hipLaunchKernelGGL(hybrid_fwd, dim3(grid), dim3(NTHR), LDS_BYTES, stream, p); }
#endif
}
```

```cpp
#include <hip/hip_runtime.h>
#include <hip/hip_cooperative_groups.h>
#include <cstdio>
namespace cg = cooperative_groups;
namespace pg8 {
#define PG8_LAS __attribute__((address_space(3)))
typedef unsigned short bf16_t;
typedef short bf16x8 __attribute__((ext_vector_type(8)));
typedef float f32x4 __attribute__((ext_vector_type(4)));
typedef unsigned u32x4 __attribute__((ext_vector_type(4)));
constexpr int BM = 256, BK = 64, HALF = 128, HTB = HALF * BK * 2  , STAGE_BYTES = 8 * HTB, NXCD = 8, WGM = 4;

__host__ __device__ __forceinline__ int lds_byte(int r, int c) { const int st = (r >> 4) * 2 + (c >> 5), rr = r & 15, cc = c & 31, ob = rr * 64 + cc * 2; return st * 1024 + (ob ^ (((ob >> 9) & 1) << 5)); }
__host__ __device__ __forceinline__ void stage_rc(int b, int& R, int& C) { const int st = b / 1024, sb = b % 1024, swz = sb ^ (((sb >> 9) & 1) << 5); R = (st >> 1) * 16 + swz / 64; C = (st & 1) * 32 + (swz % 64) / 2; }
__host__ __device__ __forceinline__ int perm32(int rho) { const int n = rho >> 4, i = rho & 15; return 8 * (i >> 2) + 4 * n + (i & 3); }

struct Unit { int pm, pn; };
struct Gemm { const bf16_t* A; const bf16_t* Bt; int M, N, K; };

struct StaticOrder {
    int nM, nN, nwg, G, c;
    __host__ __device__ void init(int M, int N, int G_, int c_) { nM = M / BM; nN = N / BM; nwg = nM * nN; G = G_; c = c_; }
    __host__ __device__ bool next(int i, Unit& u) const {
        const long L = (long)i * G + c; if (L >= nwg) return false;
        int wgid = (int)L; { const int q = nwg / NXCD, r = nwg % NXCD, xcd = wgid % NXCD, off = wgid / NXCD; wgid = (xcd < r ? xcd * (q + 1) : r * (q + 1) + (xcd - r) * q) + off; }
        const int nig = WGM * nN, gid = wgid / nig, fm = gid * WGM, gsz = (nM - fm) < WGM ? (nM - fm) : WGM;
        u.pm = fm + ((wgid % nig) % gsz); u.pn = (wgid % nig) / gsz; return true;
    }
    __device__ __forceinline__ void a_ready(const Unit&) const {}
    __device__ __forceinline__ void done(const Unit&) const {}
};
__device__ __forceinline__ unsigned cvt_pk_bf16(float lo, float hi) { unsigned r; asm volatile("v_cvt_pk_bf16_f32 %0, %1, %2" : "=v"(r) : "v"(lo), "v"(hi)); return r; }
typedef float f32x2 __attribute__((ext_vector_type(2)));
template <class Epi, class Sched, bool STAMP = false>
__device__ __forceinline__ void gemm_phase(PG8_LAS unsigned char* lds, const Gemm g, const Sched& S, const Epi& E, unsigned long long* stamps) {
    const int tid = threadIdx.x, wid = __builtin_amdgcn_readfirstlane(tid >> 6), lane = tid & 63, wr = wid >> 2, wc = wid & 3, fr = lane & 15, fq = lane >> 4;
    const int K = g.K, nt = K / BK;
    int ts_lo = 0, ts_hi = 0, nts = 0; const unsigned long long rt_entry = STAMP ? (unsigned long long)wall_clock64() : 0ull;
#define PG8_STAMP() do { if (STAMP && wid == 0 && nts < 64) { const unsigned long long _c = (unsigned long long)clock64(); \
        ts_lo = (lane == nts) ? (int)(unsigned)_c : ts_lo; ts_hi = (lane == nts) ? (int)(unsigned)(_c >> 32) : ts_hi; ++nts; } } while (0)
    PG8_STAMP();
    unsigned voffA[2], voffB[2];
#pragma unroll
    for (int i = 0; i < 2; ++i) { int R, C; stage_rc(tid * 16 + i * 8192, R, C); const int Rb = ((R & ~31) + perm32(R & 31));
        voffA[i] = (unsigned)(R * K + C) * 2u; voffB[i] = (unsigned)(Rb * K + C) * 2u; }
    const size_t kstep = (size_t)(BK * 2);
    const size_t hstep = (size_t)HALF * K * 2;
    const size_t tstep = 2 * hstep;
    const unsigned ldsw = (unsigned)wid * 1024u;
    const int aoff = lds_byte(wr * 64 + fr, fq * 8), boff = lds_byte(wc * 32 + fr, fq * 8);
#define PG8_SA(b, h) (((b) * 2 + (h)) * HTB)
#define PG8_SB(b, h) ((4 + (b) * 2 + (h)) * HTB)
#define PG8_STAGE(bufoff, gbase, voff) do { _Pragma("unroll") for (int _i = 0; _i < 2; ++_i) \
        __builtin_amdgcn_global_load_lds((const unsigned*)((const char*)(gbase) + (voff)[_i]), (PG8_LAS unsigned*)(lds + (bufoff) + ldsw + _i * 8192), 16, 0, 0); } while (0)
#define PG8_LDA(dst, b, h) do { _Pragma("unroll") for (int m = 0; m < 4; ++m) _Pragma("unroll") for (int k = 0; k < 2; ++k) dst[m][k] = *(const PG8_LAS bf16x8*)(lds + PG8_SA(b, h) + aoff + m * 2048 + k * 1024); } while (0)
#define PG8_LDB(dst, b, h) do { _Pragma("unroll") for (int n = 0; n < 2; ++n) _Pragma("unroll") for (int k = 0; k < 2; ++k) dst[n][k] = *(const PG8_LAS bf16x8*)(lds + PG8_SB(b, h) + boff + n * 2048 + k * 1024); } while (0)
#define PG8_MMA(ai, bj, At, Bt) do { __builtin_amdgcn_s_setprio(1); _Pragma("unroll") for (int m = 0; m < 4; ++m) _Pragma("unroll") for (int n = 0; n < 2; ++n) _Pragma("unroll") for (int k = 0; k < 2; ++k) \
        acc[ai][bj][m][n] = __builtin_amdgcn_mfma_f32_16x16x32_bf16(Bt[n][k], At[m][k], acc[ai][bj][m][n], 0, 0, 0); __builtin_amdgcn_s_setprio(0); } while (0)
#define PG8_WAIT_V(n) asm volatile("s_waitcnt vmcnt(" #n ")" ::: "memory")
#define PG8_WAIT_L(n) asm volatile("s_waitcnt lgkmcnt(" #n ")" ::: "memory")
#define PG8_BAR __builtin_amdgcn_s_barrier()
#define PG8_SCHED __builtin_amdgcn_sched_barrier(0)
    Unit cur, nxt; int ui = 0;
    if (!S.next(0, cur)) return;
    f32x4 acc[2][2][4][2];
#pragma unroll
    for (int a = 0; a < 2; ++a)
#pragma unroll
        for (int b = 0; b < 2; ++b)
#pragma unroll
            for (int m = 0; m < 4; ++m)
#pragma unroll
                for (int n = 0; n < 2; ++n) acc[a][b][m][n] = (f32x4){0.f, 0.f, 0.f, 0.f};
    bf16x8 At[4][2], B0[2][2], B1[2][2];
    const char* cA = (const char*)g.A + (size_t)cur.pm * tstep; const char* cB = (const char*)g.Bt + (size_t)cur.pn * tstep;
    S.a_ready(cur);
    PG8_STAGE(PG8_SB(0, 0), cB, voffB); PG8_STAGE(PG8_SA(0, 0), cA, voffA); PG8_STAGE(PG8_SB(0, 1), cB + hstep, voffB); PG8_STAGE(PG8_SA(0, 1), cA + hstep, voffA);
    if (wr == 1) PG8_BAR;
    PG8_WAIT_V(4); PG8_BAR;
    PG8_STAGE(PG8_SB(1, 0), cB + kstep, voffB); PG8_STAGE(PG8_SA(1, 0), cA + kstep, voffA); PG8_STAGE(PG8_SB(1, 1), cB + hstep + kstep, voffB);
    PG8_WAIT_V(6); PG8_BAR;
    PG8_STAMP();
    for (;;) {
        const bool has_next = S.next(ui + 1, nxt);
        const char* nA = has_next ? (const char*)g.A + (size_t)nxt.pm * tstep : cA; const char* nB = has_next ? (const char*)g.Bt + (size_t)nxt.pn * tstep : cB;
        for (int t = 0; t < nt; t += 2) {
            const bool last = (t == nt - 2);
            const char* a1 = cA + (size_t)(t + 1) * kstep;
            const char* a2 = last ? nA : cA + (size_t)(t + 2) * kstep; const char* b2 = last ? nB : cB + (size_t)(t + 2) * kstep;
            const char* a3 = a2 + kstep; const char* b3 = b2 + kstep;
            E.hook(acc, cur, t, wr, wc, fr, fq);
            if (last && has_next) S.a_ready(nxt);
            PG8_LDB(B0, 0, 0); PG8_SCHED; PG8_LDA(At, 0, 0); PG8_STAGE(PG8_SA(1, 1), a1 + hstep, voffA);
            PG8_WAIT_L(8); PG8_BAR; PG8_WAIT_L(0); PG8_MMA(0, 0, At, B0); PG8_BAR; PG8_SCHED;
            PG8_LDB(B1, 0, 1); PG8_STAGE(PG8_SB(0, 0), b2, voffB);
            PG8_BAR; PG8_WAIT_L(0); PG8_MMA(0, 1, At, B1); PG8_BAR;
            PG8_LDA(At, 0, 1); PG8_STAGE(PG8_SA(0, 0), a2, voffA);
            PG8_BAR; PG8_WAIT_L(0); PG8_MMA(1, 0, At, B0); PG8_BAR; PG8_SCHED;
            PG8_STAGE(PG8_SB(0, 1), b2 + hstep, voffB);
            PG8_WAIT_V(6); PG8_BAR; PG8_MMA(1, 1, At, B1); PG8_BAR;
            PG8_LDB(B0, 1, 0); PG8_SCHED; PG8_LDA(At, 1, 0); PG8_STAGE(PG8_SA(0, 1), a2 + hstep, voffA);
            PG8_WAIT_L(8); PG8_BAR; PG8_WAIT_L(0); PG8_MMA(0, 0, At, B0); PG8_BAR; PG8_SCHED;
            PG8_LDB(B1, 1, 1); PG8_STAGE(PG8_SB(1, 0), b3, voffB);
            PG8_BAR; PG8_WAIT_L(0); PG8_MMA(0, 1, At, B1); PG8_BAR;
            PG8_LDA(At, 1, 1); PG8_STAGE(PG8_SA(1, 0), a3, voffA);
            PG8_BAR; PG8_WAIT_L(0); PG8_MMA(1, 0, At, B0); PG8_BAR; PG8_SCHED;
            PG8_STAGE(PG8_SB(1, 1), b3 + hstep, voffB);
            PG8_WAIT_V(6); PG8_BAR; PG8_MMA(1, 1, At, B1); PG8_BAR;
        }
        PG8_STAMP();
        if constexpr (!Epi::AFTER_DRAIN) { E(acc, cur, wr, wc, fr, fq); S.done(cur); }
        PG8_STAMP();
        if (!has_next) break;
#pragma unroll
        for (int a = 0; a < 2; ++a)
#pragma unroll
            for (int b = 0; b < 2; ++b)
#pragma unroll
                for (int m = 0; m < 4; ++m)
#pragma unroll
                    for (int n = 0; n < 2; ++n) acc[a][b][m][n] = (f32x4){0.f, 0.f, 0.f, 0.f};
        cur = nxt; cA = nA; cB = nB; ++ui;
    }
    PG8_WAIT_V(0);
    if (wr == 0) PG8_BAR;
    PG8_BAR;
    if constexpr (Epi::AFTER_DRAIN) { E.fused(acc, cur, wr, wc, fr, fq, lds, wid, lane); S.done(cur); }
    PG8_STAMP();
    if (STAMP && wid == 0) { stamps[lane] = lane < nts ? (((unsigned long long)(unsigned)ts_hi << 32) | (unsigned)ts_lo) : 0ull;
        if (lane == 62) stamps[62] = rt_entry; if (lane == 63) stamps[63] = (unsigned long long)wall_clock64(); }
#undef PG8_STAMP
#undef PG8_SA
#undef PG8_SB
#undef PG8_STAGE
#undef PG8_LDA
#undef PG8_LDB
#undef PG8_MMA
#undef PG8_WAIT_V
#undef PG8_WAIT_L
#undef PG8_BAR
#undef PG8_SCHED
}
}

#define XB_TMO      128
#define XB_XCNT(j)  (256  + 64 * (j))
#define XB_XSUB(j)  (1280 + 64 * (j))
#define XB_XGEN(j)  (2304 + 64 * (j))
#define XB_TOP      3328
#define XB_TOPGEN   3392
#define XCD_BAR_WORDS 3456
#define XB_SPIN_CAP (1u << 18)
#define LAS __attribute__((address_space(3)))

__device__ __forceinline__ unsigned xb_ld(unsigned* p)              { return __hip_atomic_load(p, __ATOMIC_RELAXED, __HIP_MEMORY_SCOPE_AGENT); }
__device__ __forceinline__ unsigned xb_add(unsigned* p, unsigned v) { return __hip_atomic_fetch_add(p, v, __ATOMIC_RELAXED, __HIP_MEMORY_SCOPE_AGENT); }
__device__ __forceinline__ unsigned xb_xcc_id() { return (unsigned)__builtin_amdgcn_s_getreg((3 << 11) | 20) & 0xFu; }
#define XB_SPIN(cond, bar) do { unsigned _sp = 0; while (cond) { __builtin_amdgcn_s_sleep(1); \
    if ((++_sp & 255u) == 0u) { if (xb_ld(&(bar)[XB_TMO])) break; if (_sp > XB_SPIN_CAP) { atomicAdd(&(bar)[XB_TMO], 1u); break; } } } } while (0)

struct XcdBarrier {
    unsigned* bar; unsigned x;
    volatile LAS unsigned* st;
};

__device__ __forceinline__ XcdBarrier xcd_barrier_post(unsigned* bar, volatile LAS unsigned* st) {
    XcdBarrier b; b.bar = bar; b.x = xb_xcc_id(); b.st = st;
    if (threadIdx.x == 0) (void)xb_add(&bar[XB_XCNT(b.x)], 1u);
    return b;
}
__device__ __forceinline__ void xcd_barrier_complete(unsigned* bar, unsigned x, unsigned& nloc, unsigned& nx) {
    const unsigned G = gridDim.x * gridDim.y * gridDim.z;
    unsigned sum, cnt, mine, sp = 0u;
    for (;;) {
        sum = 0u; cnt = 0u; mine = 0u;
#pragma unroll
        for (unsigned j = 0; j < 16; ++j) { const unsigned c = xb_ld(&bar[XB_XCNT(j)]); sum += c; cnt += (c > 0u) ? 1u : 0u; mine = (j == x) ? c : mine; }
        if (sum == G) break;
        __builtin_amdgcn_s_sleep(1);
        if ((++sp & 255u) == 0u) { if (xb_ld(&bar[XB_TMO])) break; if (sp > XB_SPIN_CAP) { atomicAdd(&bar[XB_TMO], 1u); break; } }
    }
    nloc = mine > 0u ? mine : 1u; nx = cnt > 0u ? cnt : 1u;
}

__device__ __forceinline__ void xcd_barrier(const XcdBarrier& b) {
    asm volatile("s_waitcnt vmcnt(0)" ::: "memory");
    __syncthreads();
    if (threadIdx.x == 0) {
        unsigned* bar = b.bar;
        __builtin_amdgcn_s_waitcnt(0);
        unsigned nloc = b.st[0], nx = b.st[1];
        if (nloc == 0u) { xcd_barrier_complete(bar, b.x, nloc, nx); b.st[0] = nloc; b.st[1] = nx; }
        const unsigned old = xb_add(&bar[XB_XSUB(b.x)], 1u);
        const unsigned gen = old / nloc;
        if (old + 1u == (gen + 1u) * nloc) {
            __builtin_amdgcn_fence(__ATOMIC_RELEASE, "agent");
            asm volatile("s_waitcnt vmcnt(0)" ::: "memory");
            const unsigned og = xb_add(&bar[XB_TOP], 1u);
            const unsigned tg = og / nx;
            if (og + 1u == (tg + 1u) * nx) xb_add(&bar[XB_TOPGEN], 1u);
            else XB_SPIN(xb_ld(&bar[XB_TOPGEN]) == tg, bar);
            __builtin_amdgcn_fence(__ATOMIC_ACQUIRE, "agent");
            xb_add(&bar[XB_XGEN(b.x)], 1u);
            asm volatile("s_waitcnt vmcnt(0)" ::: "memory");
        } else {
            XB_SPIN(xb_ld(&bar[XB_XGEN(b.x)]) == gen, bar);
            __builtin_amdgcn_fence(__ATOMIC_ACQUIRE, "agent");
            asm volatile("s_waitcnt vmcnt(0)" ::: "memory");
        }
    }
    __syncthreads();
}

typedef unsigned short u16;
typedef unsigned int u32;
typedef short bf16x8 __attribute__((ext_vector_type(8)));
typedef float f32x4 __attribute__((ext_vector_type(4)));
typedef u32 u32x4 __attribute__((ext_vector_type(4)));
typedef u32 u32x2 __attribute__((ext_vector_type(2)));
typedef __bf16 bf16x2_t __attribute__((ext_vector_type(2)));

constexpr int S_ = 16384, D_ = 2048, INW = 9216;
constexpr int C_Q = 0, C_K = 1024, C_V = 1280, C_CA = 1536, C_CB = 2048, C_MQ = 2560, C_GA = 3072, C_GC = 5120, C_GM = 7168;
constexpr float EPS_ = 1e-6f, LOG2E = 1.4426950408889634f;
constexpr int LDS_BYTES = 155648, NTHR = 512;

constexpr size_t WS_WIN_T = 4096;
constexpr size_t WS_WA_T = WS_WIN_T + (size_t)INW * D_ * 2;
constexpr size_t WS_WC_T = WS_WA_T + (size_t)2048 * 1024 * 2;
constexpr size_t WS_WM_T = WS_WC_T + (size_t)2048 * 512 * 2;
constexpr size_t WS_WKV_T = WS_WM_T + (size_t)2048 * 512 * 2;
constexpr size_t WS_WOUT_T = WS_WKV_T + (size_t)1024 * 2048 * 2;
constexpr size_t WS_WQ_T = WS_WOUT_T + (size_t)2048 * 2048 * 2;
constexpr size_t WS_SK = WS_WQ_T + (size_t)2048 * 2048 * 2;
constexpr size_t WS_MEMN = WS_SK + (size_t)16 * 128 * 128 * 2;
constexpr size_t WS_MEMKV = WS_MEMN + (size_t)256 * 2048 * 2;
constexpr size_t WS_COS = WS_MEMKV + (size_t)256 * 1024 * 2;
constexpr size_t WS_SIN = WS_COS + (size_t)S_ * 32 * 4;
constexpr size_t WS_MERGED = WS_SIN + (size_t)S_ * 32 * 4;
constexpr size_t WS_PROJ = WS_MERGED + (size_t)S_ * D_ * 2;
constexpr size_t WS_EV = WS_PROJ + (size_t)16384 * 2048;
constexpr size_t WS_Q = WS_EV + (size_t)16384 * 2048;
constexpr size_t WS_SI = WS_Q + (size_t)S_ * 2048 * 2;
constexpr size_t WS_SG = WS_SI + (size_t)S_ * 128 * 4;
constexpr size_t WS_SGU = WS_SG + (size_t)S_ * 128 * 4;
constexpr size_t WS_END = WS_PROJ + (size_t)S_ * INW * 2;
constexpr size_t WS_BAR = WS_END;
constexpr size_t WS_EU = WS_BAR + 16384;
constexpr size_t WS_SUI = WS_EU + (size_t)16384 * 3072;
constexpr size_t WS_SVI = WS_SUI + (size_t)16384 * 4;
constexpr size_t WS_TOTAL = WS_SVI + (size_t)16384 * 4;
static_assert(WS_SGU + (size_t)S_ * 128 * 4 <= WS_END, "peer scratch must fit the dead proj region");

struct Params {
    const float* x; const float* mem; const int* pos; const float* g_mix; const float* w_in; const float* qg; const float* kg; const float* sinks;
    const float* w_attn_o; const float* dw_w; const float* dw_b; const float* ln_g; const float* ln_b; const float* w_conv_o; const float* g_mem;
    const float* w_mem_kv; const float* mqg; const float* mkg; const float* w_mem_o; const float* w_out; const float* g_ffn; const float* w_query;
    const float* sub_keys; const float* eu; const float* ev;
    float* out; unsigned char* ws; int ph_lo, ph_hi;
};

__device__ __forceinline__ u32 pk_bf16(float lo, float hi) { u32 r; asm("v_cvt_pk_bf16_f32 %0, %1, %2" : "=v"(r) : "v"(lo), "v"(hi)); return r; }
__device__ __forceinline__ float bf_lo(u32 w) { return __uint_as_float(w << 16); }
__device__ __forceinline__ float bf_hi(u32 w) { return __uint_as_float(w & 0xffff0000u); }
__device__ __forceinline__ float fast_sigmoid(float x) { return __builtin_amdgcn_rcpf(1.f + __builtin_amdgcn_exp2f(-x * LOG2E)); }
template <int CTRL> __device__ __forceinline__ float dppf(float v) { return __builtin_bit_cast(float, __builtin_amdgcn_update_dpp(0, __builtin_bit_cast(int, v), CTRL, 0xf, 0xf, true)); }
__device__ __forceinline__ float row_sum16(float v) { v += dppf<0xB1>(v); v += dppf<0x4E>(v); v += dppf<0x141>(v); v += dppf<0x140>(v); return v; }
__device__ __forceinline__ float grp8_sum(float v) { v += dppf<0xB1>(v); v += dppf<0x4E>(v); v += dppf<0x141>(v); return v; }
__device__ __forceinline__ float shx(float v, int lane, int m) { return __builtin_bit_cast(float, __builtin_amdgcn_ds_bpermute((lane ^ m) << 2, __builtin_bit_cast(int, v))); }
__device__ __forceinline__ float rdlane(float v, int l) { return __builtin_bit_cast(float, __builtin_amdgcn_readlane(__builtin_bit_cast(int, v), l)); }
__device__ __forceinline__ float wave_sum(float v) { v = row_sum16(v); return (rdlane(v, 0) + rdlane(v, 16)) + (rdlane(v, 32) + rdlane(v, 48)); }
__device__ __forceinline__ float dot2bf(u32 a, u32 b, float acc) { return __builtin_amdgcn_fdot2_f32_bf16(__builtin_bit_cast(bf16x2_t, a), __builtin_bit_cast(bf16x2_t, b), acc, false); }
__device__ __forceinline__ f32x4 mfma16(bf16x8 a, bf16x8 b, f32x4 c) { return __builtin_amdgcn_mfma_f32_16x16x32_bf16(a, b, c, 0, 0, 0); }
template <int CTRL> __device__ __forceinline__ float dppmax(float v) { return fmaxf(v, dppf<CTRL>(v)); }
__device__ __forceinline__ float wave_max(float v) { v = dppmax<0xB1>(v); v = dppmax<0x4E>(v); v = dppmax<0x141>(v); v = dppmax<0x140>(v); return fmaxf(fmaxf(rdlane(v, 0), rdlane(v, 16)), fmaxf(rdlane(v, 32), rdlane(v, 48))); }
typedef float f32x2 __attribute__((ext_vector_type(2)));
typedef float v16f __attribute__((ext_vector_type(16)));
typedef float v32f __attribute__((ext_vector_type(32)));
typedef unsigned v6u __attribute__((ext_vector_type(6)));
#ifndef FP6_INTERLEAVED
#define FP6_INTERLEAVED 1
#endif
__device__ __forceinline__ u32 mono_key(float x) { u32 u = __float_as_uint(x); return (u & 0x80000000u) ? ~u : (u | 0x80000000u); }

template <bool HOOKED> struct EpiU {
    static constexpr bool PERM = true, AFTER_DRAIN = false;
    int mode;
    u16* O; float* Of; const float* X; const u16* G; int ldc; int ldg; int sig_from;
    __device__ __forceinline__ void hook(pg8::f32x4 (&acc)[2][2][4][2], const pg8::Unit& u, int t, int wr, int wc, int fr, int fq) const {
        if (!HOOKED) return;
        if (t != 16 && t != 24) return;
        int z = 0; asm volatile("" : "+v"(z));
        const unsigned char* gc = (const unsigned char*)(G + (t == 16 ? 0 : 2048));
        const int row0 = u.pm * 256 + wr * 64 + fr + z, col0 = u.pn * 256 + wc * 32 + 8 * fq;
        const u32 off0 = ((u32)row0 * (u32)INW + (u32)col0) * 2u;
#pragma unroll
        for (int ai = 0; ai < 2; ++ai) {
            u32x4 ga[4][2], gb[4][2];
#pragma unroll
            for (int m = 0; m < 4; ++m)
#pragma unroll
                for (int bj = 0; bj < 2; ++bj) { const unsigned char* gp = gc + (off0 + (u32)(((ai * 128 + m * 16) * INW + bj * 128) * 2));
                    ga[m][bj] = *(const u32x4*)gp; gb[m][bj] = *(const u32x4*)(gp + 4096); }
#pragma unroll
            for (int m = 0; m < 4; ++m)
#pragma unroll
                for (int bj = 0; bj < 2; ++bj) { const u32x4 a = ga[m][bj], b = gb[m][bj];
                    acc[ai][bj][m][0][0] *= bf_lo(a.x) * __builtin_amdgcn_rcpf(bf_lo(b.x)); acc[ai][bj][m][0][1] *= bf_hi(a.x) * __builtin_amdgcn_rcpf(bf_hi(b.x));
                    acc[ai][bj][m][0][2] *= bf_lo(a.y) * __builtin_amdgcn_rcpf(bf_lo(b.y)); acc[ai][bj][m][0][3] *= bf_hi(a.y) * __builtin_amdgcn_rcpf(bf_hi(b.y));
                    acc[ai][bj][m][1][0] *= bf_lo(a.z) * __builtin_amdgcn_rcpf(bf_lo(b.z)); acc[ai][bj][m][1][1] *= bf_hi(a.z) * __builtin_amdgcn_rcpf(bf_hi(b.z));
                    acc[ai][bj][m][1][2] *= bf_lo(a.w) * __builtin_amdgcn_rcpf(bf_lo(b.w)); acc[ai][bj][m][1][3] *= bf_hi(a.w) * __builtin_amdgcn_rcpf(bf_hi(b.w)); }
            __builtin_amdgcn_sched_barrier(0); }
    }
    __device__ __forceinline__ void operator()(const pg8::f32x4 (&acc)[2][2][4][2], const pg8::Unit& u, int wr, int wc, int fr, int fq) const {
        const int row0 = u.pm * 256 + wr * 64 + fr, col0 = u.pn * 256 + wc * 32 + 8 * fq;
        if (mode == 0) {
            const bool sg = (u.pn * 256) >= sig_from;
#pragma unroll
            for (int ai = 0; ai < 2; ++ai)
#pragma unroll
                for (int m = 0; m < 4; ++m) { u16* rowp = O + (size_t)(row0 + ai * 128 + m * 16) * ldc + col0;
#pragma unroll
                    for (int bj = 0; bj < 2; ++bj) { f32x4 v0 = acc[ai][bj][m][0], v1 = acc[ai][bj][m][1];
                        if (sg) {
#pragma unroll
                            for (int j = 0; j < 4; ++j) { v0[j] = fmaxf(fast_sigmoid(v0[j]), 1e-30f); v1[j] = fmaxf(fast_sigmoid(v1[j]), 1e-30f); } }
                        u32x4 w; w.x = pk_bf16(v0[0], v0[1]); w.y = pk_bf16(v0[2], v0[3]); w.z = pk_bf16(v1[0], v1[1]); w.w = pk_bf16(v1[2], v1[3]);
                        *(u32x4*)(rowp + bj * 128) = w; } }
        } else if (mode == 1) {
#pragma unroll
            for (int ai = 0; ai < 2; ++ai) { u32x4 g[4][2];
#pragma unroll
                for (int m = 0; m < 4; ++m)
#pragma unroll
                    for (int bj = 0; bj < 2; ++bj) g[m][bj] = *(const u32x4*)(G + 4096 + (size_t)(row0 + ai * 128 + m * 16) * ldg + col0 + bj * 128);
#pragma unroll
                for (int m = 0; m < 4; ++m) { const size_t r = (size_t)(row0 + ai * 128 + m * 16);
#pragma unroll
                    for (int bj = 0; bj < 2; ++bj) { const f32x4 v0 = acc[ai][bj][m][0], v1 = acc[ai][bj][m][1]; const u32x4 gg = g[m][bj];
                        u32x4 w;
                        w.x = pk_bf16(bf_lo(gg.x) * v0[0], bf_hi(gg.x) * v0[1]); w.y = pk_bf16(bf_lo(gg.y) * v0[2], bf_hi(gg.y) * v0[3]);
                        w.z = pk_bf16(bf_lo(gg.z) * v1[0], bf_hi(gg.z) * v1[1]); w.w = pk_bf16(bf_lo(gg.w) * v1[2], bf_hi(gg.w) * v1[3]);
                        *(u32x4*)(O + r * ldc + col0 + bj * 128) = w; } } }
        } else {
#pragma unroll
            for (int ai = 0; ai < 2; ++ai) { f32x4 xv[4][2][2];
#pragma unroll
                for (int m = 0; m < 4; ++m)
#pragma unroll
                    for (int bj = 0; bj < 2; ++bj) { const size_t o = (size_t)(row0 + ai * 128 + m * 16) * ldc + col0 + bj * 128;
                        xv[m][bj][0] = *(const f32x4*)(X + o); xv[m][bj][1] = *(const f32x4*)(X + o + 4); }
#pragma unroll
                for (int m = 0; m < 4; ++m)
#pragma unroll
                    for (int bj = 0; bj < 2; ++bj) { const size_t o = (size_t)(row0 + ai * 128 + m * 16) * ldc + col0 + bj * 128;
                        *(f32x4*)(Of + o) = xv[m][bj][0] + acc[ai][bj][m][0]; *(f32x4*)(Of + o + 4) = xv[m][bj][1] + acc[ai][bj][m][1]; } }
        }
    }
};

__device__ __forceinline__ void cvt_tr_tile4(const float* __restrict__ src, u16* __restrict__ dst, int R, int C, int tile0, float* T, int ldd) {
    const int ntc = C >> 6, tid = threadIdx.x;
    f32x4 v[4][2];
#pragma unroll
    for (int q = 0; q < 4; ++q) { const int tile = tile0 + q, tr = tile / ntc, tc = tile - tr * ntc;
#pragma unroll
        for (int i = 0; i < 2; ++i) { const int idx = tid + i * NTHR, r = idx >> 4, c4 = idx & 15; v[q][i] = *(const f32x4*)(src + (size_t)(tr * 64 + r) * C + tc * 64 + c4 * 4); } }
#pragma unroll
    for (int q = 0; q < 4; ++q)
#pragma unroll
        for (int i = 0; i < 2; ++i) { const int idx = tid + i * NTHR, r = idx >> 4, c4 = idx & 15; float* t = T + q * 4160 + r * 65 + c4 * 4; t[0] = v[q][i][0]; t[1] = v[q][i][1]; t[2] = v[q][i][2]; t[3] = v[q][i][3]; }
    __syncthreads();
#pragma unroll
    for (int q = 0; q < 4; ++q) { const int tile = tile0 + q, tr = tile / ntc, tc = tile - tr * ntc; const int c = tid >> 3, r0 = (tid & 7) * 8; float x[8];
#pragma unroll
        for (int j = 0; j < 8; ++j) x[j] = T[q * 4160 + (r0 + j) * 65 + c];
        u32x4 w; w.x = pk_bf16(x[0], x[1]); w.y = pk_bf16(x[2], x[3]); w.z = pk_bf16(x[4], x[5]); w.w = pk_bf16(x[6], x[7]);
        *(u32x4*)(dst + (size_t)(tc * 64 + c) * ldd + tr * 64 + r0) = w; }
    __syncthreads();
}
template <int NR> __device__ __forceinline__ void rms_rows(const float* __restrict__ x, const float* __restrict__ g, u16* __restrict__ out, size_t rstride, int lane) {
    f32x4 v[NR][8]; float ss[NR];
#pragma unroll
    for (int q = 0; q < NR; ++q) { ss[q] = 0.f;
#pragma unroll
        for (int i = 0; i < 8; ++i) v[q][i] = ((const f32x4*)(x + q * rstride))[i * 64 + lane]; }
#pragma unroll
    for (int q = 0; q < NR; ++q) {
#pragma unroll
        for (int i = 0; i < 8; ++i) ss[q] += v[q][i][0] * v[q][i][0] + v[q][i][1] * v[q][i][1] + v[q][i][2] * v[q][i][2] + v[q][i][3] * v[q][i][3];
        ss[q] = rsqrtf(wave_sum(ss[q]) * (1.f / 2048.f) + EPS_); }
#pragma unroll
    for (int i = 0; i < 8; ++i) { const f32x4 gg = ((const f32x4*)g)[i * 64 + lane];
#pragma unroll
        for (int q = 0; q < NR; ++q) { const float rs = ss[q];
            u32x2 w; w.x = pk_bf16(v[q][i][0] * rs * gg[0], v[q][i][1] * rs * gg[1]); w.y = pk_bf16(v[q][i][2] * rs * gg[2], v[q][i][3] * rs * gg[3]);
            ((u32x2*)(out + q * rstride))[i * 64 + lane] = w; } }
}
__device__ __forceinline__ void sincos_d(double r, double& s, double& c) {
    const double r2 = r * r; double ts = 1.0, tc = 1.0;
    double ss = 0.0, cc = 0.0;
    double term_s = 1.0, term_c = 1.0; ss = 1.0; cc = 1.0;
#pragma unroll
    for (int k = 1; k <= 15; ++k) { term_c *= -r2 / (double)((2 * k - 1) * (2 * k)); term_s *= -r2 / (double)((2 * k) * (2 * k + 1)); cc += term_c; ss += term_s; }
    (void)ts; (void)tc;
    s = r * ss; c = cc;
}
__device__ __forceinline__ void phase_prep(const Params& p, unsigned char* lds) {
    float* T = (float*)lds;
    unsigned char* ws = p.ws;
    const int tid = threadIdx.x, lane = tid & 63, wave = tid >> 6;
    for (int j = blockIdx.x * 4; j < 4608 + 512; j += gridDim.x * 4) {
        if (j < 4608) cvt_tr_tile4(p.w_in, (u16*)(ws + WS_WIN_T), 2048, INW, j, T, 2048);
        else cvt_tr_tile4(p.w_mem_kv, (u16*)(ws + WS_WKV_T), 2048, 1024, j - 4608, T, 2048);
    }
    { const int nw = gridDim.x * 8, w0 = blockIdx.x * 8 + wave;
        for (int r = w0; r < S_; r += 4 * nw) {
            if (r + 3 * nw < S_) rms_rows<4>(p.x + (size_t)r * D_, p.g_mix, (u16*)p.out + (size_t)r * D_, (size_t)nw * D_, lane);
            else for (int q = r; q < S_; q += nw) rms_rows<1>(p.x + (size_t)q * D_, p.g_mix, (u16*)p.out + (size_t)q * D_, 0, lane); }
        for (int r = w0; r < 256; r += nw) rms_rows<1>(p.mem + (size_t)r * D_, p.g_mem, (u16*)(ws + WS_MEMN) + (size_t)r * D_, 0, lane); }
}

#ifndef MIXDUP
#define MIXDUP 0
#endif
#ifndef MIX_MASK
#define MIX_MASK 7
#endif
struct SwaPre { u32x2 kra[3], krb[3]; f32x4 kcs[3], ksn[3]; u32x4 vr[3]; };
__device__ __forceinline__ void swa_preload(const Params& p, const int item, const int tid_in, SwaPre& R) {
    int zi = 0; asm volatile("" : "+v"(zi)); const int tid = tid_in + zi;
    const u16* __restrict__ proj = (const u16*)(p.ws + WS_PROJ);
    const float* __restrict__ COS = (const float*)(p.ws + WS_COS); const float* __restrict__ SIN = (const float*)(p.ws + WS_SIN);
    const int qt = item >> 2, kh = item & 3, t0 = qt * 64;
#pragma unroll
    for (int ps = 0; ps < 3; ++ps) { const int idx = ps * NTHR + tid, key = idx >> 3, l8 = idx & 7; int t = t0 - 128 + key; t = t < 0 ? 0 : t;
        const u16* kp = proj + (size_t)t * INW + C_K + kh * 64 + l8 * 4;
        R.kra[ps] = *(const u32x2*)kp; R.krb[ps] = *(const u32x2*)(kp + 32); R.kcs[ps] = *(const f32x4*)(COS + t * 32 + l8 * 4); R.ksn[ps] = *(const f32x4*)(SIN + t * 32 + l8 * 4);
        const int kb = idx >> 6, vkey = (kb >> 1) * 16 + (idx & 15), c8 = (kb & 1) * 4 + ((idx >> 4) & 3); int tv = t0 - 128 + vkey; tv = tv < 0 ? 0 : tv;
        R.vr[ps] = *(const u32x4*)(proj + (size_t)tv * INW + C_V + kh * 64 + c8 * 8); }
}
__device__ __forceinline__ void swa_item(const Params& p, int item, unsigned char* lds, float mbound_nat, const int tid_in, SwaPre& R, const int next_item) {
    int zi = 0; asm volatile("" : "+v"(zi)); const int tid = tid_in + zi;
    const u16* __restrict__ proj = (const u16*)(p.ws + WS_PROJ);
    const float* __restrict__ COS = (const float*)(p.ws + WS_COS); const float* __restrict__ SIN = (const float*)(p.ws + WS_SIN);
    u16* Ks = (u16*)lds;
    constexpr int VSTR = 200; u16* Vt = (u16*)(lds + 27648);
    const int qt = item >> 2, kh = item & 3, t0 = qt * 64;
    const int lane = tid & 63, wave = tid >> 6, fr = lane & 15, fq = lane >> 4;
    const f32x4 g1 = *(const f32x4*)(p.kg + (tid & 7) * 4), g2 = *(const f32x4*)(p.kg + 32 + (tid & 7) * 4);
#pragma unroll
    for (int ps = 0; ps < 3; ++ps) { const int idx = ps * NTHR + tid, key = idx >> 3, l8 = idx & 7, t = t0 - 128 + key;
        const bool ok = t >= 0; const u32x2 a = R.kra[ps], b = R.krb[ps];
        float x[8];
        x[0] = ok ? bf_lo(a.x) : 0.f; x[1] = ok ? bf_hi(a.x) : 0.f; x[2] = ok ? bf_lo(a.y) : 0.f; x[3] = ok ? bf_hi(a.y) : 0.f;
        x[4] = ok ? bf_lo(b.x) : 0.f; x[5] = ok ? bf_hi(b.x) : 0.f; x[6] = ok ? bf_lo(b.y) : 0.f; x[7] = ok ? bf_hi(b.y) : 0.f;
        const f32x4 cs = R.kcs[ps], sn = R.ksn[ps];
        float ss = 0.f;
#pragma unroll
        for (int j = 0; j < 8; ++j) ss += x[j] * x[j];
        ss = grp8_sum(ss);
        const float rs = rsqrtf(ss * (1.f / 64.f) + EPS_);
        float o1[4], o2[4];
#pragma unroll
        for (int j = 0; j < 4; ++j) { const float y1 = x[j] * rs * g1[j], y2 = x[4 + j] * rs * g2[j]; o1[j] = y1 * cs[j] - y2 * sn[j]; o2[j] = y2 * cs[j] + y1 * sn[j]; }
        u32x2 w1, w2; w1.x = pk_bf16(o1[0], o1[1]); w1.y = pk_bf16(o1[2], o1[3]); w2.x = pk_bf16(o2[0], o2[1]); w2.y = pk_bf16(o2[2], o2[3]);
        *(u32x2*)(Ks + key * 72 + l8 * 4) = w1; *(u32x2*)(Ks + key * 72 + 32 + l8 * 4) = w2; }
#pragma unroll
    for (int ps = 0; ps < 3; ++ps) { const int idx = ps * NTHR + tid, kb = idx >> 6, key = (kb >> 1) * 16 + (idx & 15), c8 = (kb & 1) * 4 + ((idx >> 4) & 3), t = t0 - 128 + key;
        u32x4 w = R.vr[ps]; if (t < 0) w = (u32x4){0u, 0u, 0u, 0u};
        u16* vp = Vt + (c8 * 8) * VSTR + key;
        vp[0] = (u16)w.x; vp[VSTR] = (u16)(w.x >> 16); vp[2 * VSTR] = (u16)w.y; vp[3 * VSTR] = (u16)(w.y >> 16);
        vp[4 * VSTR] = (u16)w.z; vp[5 * VSTR] = (u16)(w.z >> 16); vp[6 * VSTR] = (u16)w.w; vp[7 * VSTR] = (u16)(w.w >> 16); }
    __syncthreads();
    if (next_item >= 0) swa_preload(p, next_item, tid_in, R);
    {
        const int g = wave >> 1, half = wave & 1, head = kh * 4 + g, tw0 = t0 + half * 32;
        const float sinkv = p.sinks[head];
        const float mb = fmaxf(mbound_nat, sinkv) * LOG2E;
        const float qscale = 0.125f * LOG2E;
        bf16x8 qf[2][2];
#pragma unroll
        for (int mt = 0; mt < 2; ++mt) { const int t = tw0 + mt * 16 + fr;
            const u16* qp = proj + (size_t)t * INW + C_Q + head * 64 + fq * 8;
            const u32x4 a = *(const u32x4*)qp, b = *(const u32x4*)(qp + 32);
            float x1[8], x2[8];
            x1[0] = bf_lo(a.x); x1[1] = bf_hi(a.x); x1[2] = bf_lo(a.y); x1[3] = bf_hi(a.y); x1[4] = bf_lo(a.z); x1[5] = bf_hi(a.z); x1[6] = bf_lo(a.w); x1[7] = bf_hi(a.w);
            x2[0] = bf_lo(b.x); x2[1] = bf_hi(b.x); x2[2] = bf_lo(b.y); x2[3] = bf_hi(b.y); x2[4] = bf_lo(b.z); x2[5] = bf_hi(b.z); x2[6] = bf_lo(b.w); x2[7] = bf_hi(b.w);
            float ss = 0.f;
#pragma unroll
            for (int j = 0; j < 8; ++j) ss += x1[j] * x1[j] + x2[j] * x2[j];
            ss += shx(ss, lane, 16); ss += shx(ss, lane, 32);
            const float rs = rsqrtf(ss * (1.f / 64.f) + EPS_) * qscale;
            float o1[8], o2[8];
#pragma unroll
            for (int j = 0; j < 8; ++j) { const float c = COS[t * 32 + fq * 8 + j], s = SIN[t * 32 + fq * 8 + j];
                const float y1 = x1[j] * rs * p.qg[fq * 8 + j], y2 = x2[j] * rs * p.qg[32 + fq * 8 + j];
                o1[j] = y1 * c - y2 * s; o2[j] = y2 * c + y1 * s; }
            u32x4 w1, w2;
            w1.x = pk_bf16(o1[0], o1[1]); w1.y = pk_bf16(o1[2], o1[3]); w1.z = pk_bf16(o1[4], o1[5]); w1.w = pk_bf16(o1[6], o1[7]);
            w2.x = pk_bf16(o2[0], o2[1]); w2.y = pk_bf16(o2[2], o2[3]); w2.z = pk_bf16(o2[4], o2[5]); w2.w = pk_bf16(o2[6], o2[7]);
            qf[mt][0] = __builtin_bit_cast(bf16x8, w1); qf[mt][1] = __builtin_bit_cast(bf16x8, w2); }
        f32x4 sacc[10][2];
#pragma unroll
        for (int n = 0; n < 10; ++n) { sacc[n][0] = (f32x4){0.f, 0.f, 0.f, 0.f}; sacc[n][1] = (f32x4){0.f, 0.f, 0.f, 0.f}; }
#pragma unroll
        for (int n = 0; n < 10; ++n) { const int nt = 2 * half + n;
#pragma unroll
            for (int ks = 0; ks < 2; ++ks) { const bf16x8 kf = *(const bf16x8*)(Ks + (nt * 16 + fr) * 72 + ks * 32 + fq * 8);
                sacc[n][0] = mfma16(kf, qf[0][ks], sacc[n][0]); sacc[n][1] = mfma16(kf, qf[1][ks], sacc[n][1]); } }
        __builtin_amdgcn_sched_barrier(0);
        float lsum[2] = {0.f, 0.f};
        u32x2 pw[10][2];
#pragma unroll
        for (int n = 0; n < 10; ++n) { const int nt = 2 * half + n;
#pragma unroll
            for (int mt = 0; mt < 2; ++mt) { const int t = tw0 + mt * 16 + fr; float pv[4];
#pragma unroll
                for (int j = 0; j < 4; ++j) { const int s = t0 - 128 + nt * 16 + fq * 4 + j, df = t - s;
                    const bool ok = (df >= 0) && (df < 128) && (s >= 0);
                    pv[j] = ok ? __builtin_amdgcn_exp2f(sacc[n][mt][j] - mb) : 0.f; lsum[mt] += pv[j]; }
                pw[n][mt].x = pk_bf16(pv[0], pv[1]); pw[n][mt].y = pk_bf16(pv[2], pv[3]); } }
        f32x4 oacc[4][2];
#pragma unroll
        for (int d = 0; d < 4; ++d) { oacc[d][0] = (f32x4){0.f, 0.f, 0.f, 0.f}; oacc[d][1] = (f32x4){0.f, 0.f, 0.f, 0.f}; }
#pragma unroll
        for (int kk = 0; kk < 5; ++kk) { __builtin_amdgcn_sched_barrier(0); const int nta = 2 * half + 2 * kk;
            u32x4 b0, b1; b0.x = pw[2 * kk][0].x; b0.y = pw[2 * kk][0].y; b0.z = pw[2 * kk + 1][0].x; b0.w = pw[2 * kk + 1][0].y;
            b1.x = pw[2 * kk][1].x; b1.y = pw[2 * kk][1].y; b1.z = pw[2 * kk + 1][1].x; b1.w = pw[2 * kk + 1][1].y;
            const bf16x8 pf0 = __builtin_bit_cast(bf16x8, b0), pf1 = __builtin_bit_cast(bf16x8, b1);
#pragma unroll
            for (int d = 0; d < 4; ++d) { const u16* vp = Vt + (d * 16 + fr) * VSTR + nta * 16 + fq * 4;
                const u32x2 va = *(const u32x2*)vp, vb = *(const u32x2*)(vp + 16);
                u32x4 vv; vv.x = va.x; vv.y = va.y; vv.z = vb.x; vv.w = vb.y; const bf16x8 vf = __builtin_bit_cast(bf16x8, vv);
                oacc[d][0] = mfma16(vf, pf0, oacc[d][0]); oacc[d][1] = mfma16(vf, pf1, oacc[d][1]); } }
        const float sk = __builtin_amdgcn_exp2f(sinkv * LOG2E - mb);
        u16* BOA = (u16*)((unsigned char*)p.out + 67108864);
#pragma unroll
        for (int mt = 0; mt < 2; ++mt) { float l = lsum[mt]; l += shx(l, lane, 16); l += shx(l, lane, 32); l += sk;
            const float inv = 1.f / l; const int t = tw0 + mt * 16 + fr;
#pragma unroll
            for (int d = 0; d < 4; ++d) { u32x2 w; w.x = pk_bf16(oacc[d][mt][0] * inv, oacc[d][mt][1] * inv); w.y = pk_bf16(oacc[d][mt][2] * inv, oacc[d][mt][3] * inv);
                *(u32x2*)(BOA + (size_t)t * 2048 + head * 64 + d * 16 + fq * 4) = w; } }
    }
    __syncthreads();
}

__device__ __forceinline__ void mem_item(const Params& p, int item, unsigned char* lds, float mbound_nat, const int tid_in) {
    int zi = 0; asm volatile("" : "+v"(zi)); const int tid = tid_in + zi;
    const u16* __restrict__ proj = (const u16*)(p.ws + WS_PROJ);
    const u16* __restrict__ MKV = (const u16*)(p.ws + WS_MEMKV);
    u16* Ks = (u16*)lds;
    u16* Vt = (u16*)(lds + 69632);
    const int tt = item >> 2, h = item & 3, t0 = tt * 128;
    const int lane = tid & 63, wave = tid >> 6, fr = lane & 15, fq = lane >> 4;
#pragma unroll
    for (int ps = 0; ps < 8; ++ps) { const int idx = ps * NTHR + tid, key = idx >> 4, l16 = idx & 15;
        const u32x4 a = *(const u32x4*)(MKV + (size_t)key * 1024 + h * 128 + l16 * 8);
        float x[8]; x[0] = bf_lo(a.x); x[1] = bf_hi(a.x); x[2] = bf_lo(a.y); x[3] = bf_hi(a.y); x[4] = bf_lo(a.z); x[5] = bf_hi(a.z); x[6] = bf_lo(a.w); x[7] = bf_hi(a.w);
        float ss = 0.f;
#pragma unroll
        for (int j = 0; j < 8; ++j) ss += x[j] * x[j];
        ss = row_sum16(ss);
        const float rs = rsqrtf(ss * (1.f / 128.f) + EPS_);
        const f32x4 g1 = *(const f32x4*)(p.mkg + l16 * 8), g2 = *(const f32x4*)(p.mkg + l16 * 8 + 4);
        u32x4 w; w.x = pk_bf16(x[0] * rs * g1[0], x[1] * rs * g1[1]); w.y = pk_bf16(x[2] * rs * g1[2], x[3] * rs * g1[3]);
        w.z = pk_bf16(x[4] * rs * g2[0], x[5] * rs * g2[1]); w.w = pk_bf16(x[6] * rs * g2[2], x[7] * rs * g2[3]);
        *(u32x4*)(Ks + key * 136 + l16 * 8) = w;
        const int L = ps * NTHR + tid, kblk = L >> 6, vkey = (kblk & 15) * 16 + (L & 15), vc = (kblk >> 4) * 4 + ((L >> 4) & 3);
        const u32x4 v = *(const u32x4*)(MKV + (size_t)vkey * 1024 + 512 + h * 128 + vc * 8);
        u16* vp = Vt + (vc * 8) * 264 + vkey;
        vp[0] = (u16)v.x; vp[264] = (u16)(v.x >> 16); vp[528] = (u16)v.y; vp[792] = (u16)(v.y >> 16);
        vp[1056] = (u16)v.z; vp[1320] = (u16)(v.z >> 16); vp[1584] = (u16)v.w; vp[1848] = (u16)(v.w >> 16); }
    __syncthreads();
    {
        const float mb = mbound_nat * LOG2E;
        const float qscale = 0.08838834764831845f * LOG2E;
        const int t = t0 + wave * 16 + fr;
        bf16x8 qf[4];
        { u32x4 a[4]; float ss = 0.f;
#pragma unroll
            for (int ks = 0; ks < 4; ++ks) { a[ks] = *(const u32x4*)(proj + (size_t)t * INW + C_MQ + h * 128 + ks * 32 + fq * 8);
                const float x0 = bf_lo(a[ks].x), x1 = bf_hi(a[ks].x), x2 = bf_lo(a[ks].y), x3 = bf_hi(a[ks].y), x4 = bf_lo(a[ks].z), x5 = bf_hi(a[ks].z), x6 = bf_lo(a[ks].w), x7 = bf_hi(a[ks].w);
                ss += x0 * x0 + x1 * x1 + x2 * x2 + x3 * x3 + x4 * x4 + x5 * x5 + x6 * x6 + x7 * x7; }
            ss += shx(ss, lane, 16); ss += shx(ss, lane, 32);
            const float rs = rsqrtf(ss * (1.f / 128.f) + EPS_) * qscale;
#pragma unroll
            for (int ks = 0; ks < 4; ++ks) { const float* gp = p.mqg + ks * 32 + fq * 8; u32x4 w;
                w.x = pk_bf16(bf_lo(a[ks].x) * rs * gp[0], bf_hi(a[ks].x) * rs * gp[1]); w.y = pk_bf16(bf_lo(a[ks].y) * rs * gp[2], bf_hi(a[ks].y) * rs * gp[3]);
                w.z = pk_bf16(bf_lo(a[ks].z) * rs * gp[4], bf_hi(a[ks].z) * rs * gp[5]); w.w = pk_bf16(bf_lo(a[ks].w) * rs * gp[6], bf_hi(a[ks].w) * rs * gp[7]);
                qf[ks] = __builtin_bit_cast(bf16x8, w); } }
        f32x4 sacc[16];
#pragma unroll
        for (int n = 0; n < 16; ++n) sacc[n] = (f32x4){0.f, 0.f, 0.f, 0.f};
#pragma unroll
        for (int n = 0; n < 16; ++n)
#pragma unroll
            for (int ks = 0; ks < 4; ++ks) { const bf16x8 kf = *(const bf16x8*)(Ks + (n * 16 + fr) * 136 + ks * 32 + fq * 8); sacc[n] = mfma16(kf, qf[ks], sacc[n]); }
        __builtin_amdgcn_sched_barrier(0);
        float lsum = 0.f; u32x2 pw[16];
#pragma unroll
        for (int n = 0; n < 16; ++n) { float pv[4];
#pragma unroll
            for (int j = 0; j < 4; ++j) { pv[j] = __builtin_amdgcn_exp2f(sacc[n][j] - mb); lsum += pv[j]; }
            pw[n].x = pk_bf16(pv[0], pv[1]); pw[n].y = pk_bf16(pv[2], pv[3]); }
        f32x4 oacc[8];
#pragma unroll
        for (int d = 0; d < 8; ++d) oacc[d] = (f32x4){0.f, 0.f, 0.f, 0.f};
#pragma unroll
        for (int kk = 0; kk < 8; ++kk) { __builtin_amdgcn_sched_barrier(0); u32x4 b; b.x = pw[2 * kk].x; b.y = pw[2 * kk].y; b.z = pw[2 * kk + 1].x; b.w = pw[2 * kk + 1].y;
            const bf16x8 pf = __builtin_bit_cast(bf16x8, b);
#pragma unroll
            for (int d = 0; d < 8; ++d) { const u16* vp = Vt + (d * 16 + fr) * 264 + kk * 32 + fq * 4;
                const u32x2 va = *(const u32x2*)vp, vb = *(const u32x2*)(vp + 16);
                u32x4 vv; vv.x = va.x; vv.y = va.y; vv.z = vb.x; vv.w = vb.y;
                oacc[d] = mfma16(__builtin_bit_cast(bf16x8, vv), pf, oacc[d]); } }
        lsum += shx(lsum, lane, 16); lsum += shx(lsum, lane, 32);
        const float inv = 1.f / lsum;
        u16* BOM = (u16*)((unsigned char*)p.out + 67108864) + 1536;
#pragma unroll
        for (int d = 0; d < 8; ++d) { u32x2 w; w.x = pk_bf16(oacc[d][0] * inv, oacc[d][1] * inv); w.y = pk_bf16(oacc[d][2] * inv, oacc[d][3] * inv);
            *(u32x2*)(BOM + (size_t)t * 2048 + h * 128 + d * 16 + fq * 4) = w; }
    }
    __syncthreads();
}

__device__ __forceinline__ void conv_item(const Params& p, int item, unsigned char* lds, const int tid_in) {
    int zi = 0; asm volatile("" : "+v"(zi)); const int tid = tid_in + zi;
    const u16* __restrict__ proj = (const u16*)(p.ws + WS_PROJ);
    float* G = (float*)lds;
    float* red = (float*)(lds + 126976);
    const int lane = tid & 63, wave = tid >> 6;
    const int t0 = item * 32;
    { const int c8 = (tid & 63) * 8, rr = tid >> 6;
        u32x4 av[8], bv[8];
#pragma unroll
        for (int ps = 0; ps < 8; ++ps) { const int r = ps * 8 + rr; int t = t0 - 30 + r; t = t < 0 ? 0 : (t > S_ - 1 ? S_ - 1 : t);
            av[ps] = *(const u32x4*)(proj + (size_t)t * INW + C_CA + c8); bv[ps] = *(const u32x4*)(proj + (size_t)t * INW + C_CB + c8); }
#pragma unroll
        for (int ps = 0; ps < 8; ++ps) { const int r = ps * 8 + rr, t = t0 - 30 + r;
            if (r < 62) { const bool ok = t >= 0; f32x4 g0, g1;
                g0[0] = ok ? bf_lo(av[ps].x) * fast_sigmoid(bf_lo(bv[ps].x)) : 0.f; g0[1] = ok ? bf_hi(av[ps].x) * fast_sigmoid(bf_hi(bv[ps].x)) : 0.f;
                g0[2] = ok ? bf_lo(av[ps].y) * fast_sigmoid(bf_lo(bv[ps].y)) : 0.f; g0[3] = ok ? bf_hi(av[ps].y) * fast_sigmoid(bf_hi(bv[ps].y)) : 0.f;
                g1[0] = ok ? bf_lo(av[ps].z) * fast_sigmoid(bf_lo(bv[ps].z)) : 0.f; g1[1] = ok ? bf_hi(av[ps].z) * fast_sigmoid(bf_hi(bv[ps].z)) : 0.f;
                g1[2] = ok ? bf_lo(av[ps].w) * fast_sigmoid(bf_lo(bv[ps].w)) : 0.f; g1[3] = ok ? bf_hi(av[ps].w) * fast_sigmoid(bf_hi(bv[ps].w)) : 0.f;
                *(f32x4*)(G + r * 512 + c8) = g0; *(f32x4*)(G + r * 512 + c8 + 4) = g1; } } }
    __syncthreads();
    const int ch = tid;
    const float bias = p.dw_b[ch];
    float wgt[31];
#pragma unroll
    for (int j = 0; j < 31; ++j) wgt[j] = p.dw_w[j * 512 + ch];
#pragma unroll 1
    for (int sub = 0; sub < 4; ++sub) { const int base = sub * 8;
        float g[38];
#pragma unroll
        for (int r = 0; r < 38; ++r) g[r] = G[(base + r) * 512 + ch];
        float ac[8];
#pragma unroll
        for (int o = 0; o < 8; ++o) ac[o] = bias;
#pragma unroll
        for (int j = 0; j < 31; ++j) {
#pragma unroll
            for (int o = 0; o < 8; ++o) ac[o] += wgt[j] * g[o + j]; }
#pragma unroll
        for (int o = 0; o < 8; ++o) G[(base + o) * 512 + ch] = ac[o]; }
    __syncthreads();
#pragma unroll
    for (int i = 0; i < 4; ++i) { const int row = wave * 4 + i; float sm = 0.f, sq = 0.f;
#pragma unroll
        for (int j = 0; j < 8; ++j) { const float v = G[row * 512 + j * 64 + lane]; sm += v; sq += v * v; }
        sm = wave_sum(sm); sq = wave_sum(sq);
        if (lane == 0) { red[512 + row] = sm; red[512 + 32 + row] = sq; } }
    __syncthreads();
    { const int cp2 = (tid & 255) * 2, th = tid >> 8;
        const float lgx = p.ln_g[cp2], lgy = p.ln_g[cp2 + 1], lbx = p.ln_b[cp2], lby = p.ln_b[cp2 + 1];
        u16* BOC = (u16*)((unsigned char*)p.out + 67108864) + 1024;
#pragma unroll
        for (int k = 0; k < 16; ++k) { const int tk = th * 16 + k; const float s = red[512 + tk], q = red[512 + 32 + tk];
            const float mu = s * (1.f / 512.f), var = fmaxf(q * (1.f / 512.f) - mu * mu, 0.f), rstd = rsqrtf(var + EPS_);
            const float yx = (G[tk * 512 + cp2] - mu) * rstd * lgx + lbx, yy = (G[tk * 512 + cp2 + 1] - mu) * rstd * lgy + lby;
            *(u32*)(BOC + (size_t)(t0 + tk) * 2048 + cp2) = pk_bf16(yx * fast_sigmoid(yx), yy * fast_sigmoid(yy)); } }
    __syncthreads();
}

__device__ __forceinline__ void phase_mix(const Params& p, unsigned char* lds) {
    float mq = 0.f, mk = 0.f, mmq = 0.f, mmk = 0.f;
    for (int i = 0; i < 64; ++i) { mq = fmaxf(mq, fabsf(p.qg[i])); mk = fmaxf(mk, fabsf(p.kg[i])); }
    for (int i = 0; i < 128; ++i) { mmq = fmaxf(mmq, fabsf(p.mqg[i])); mmk = fmaxf(mmk, fabsf(p.mkg[i])); }
    const float swa_bound = 8.f * mq * mk * 1.02f + 0.1f, mem_bound = 11.313708498984761f * mmq * mmk * 1.02f + 0.1f;
    if (MIX_MASK & 1) { int z = 0; asm volatile("" : "+v"(z)); const int tz = threadIdx.x + z;
#define SWA_ITEM(v) (((((v) & 7) * 32 + (((v) >> 3) & 31)) << 2) | ((v) >> 8))
        SwaPre pre; if ((int)blockIdx.x < 1024) swa_preload(p, SWA_ITEM((int)blockIdx.x), tz, pre);
        for (int it = blockIdx.x; it < 1024; it += gridDim.x) { const int nx = it + (int)gridDim.x; swa_item(p, SWA_ITEM(it), lds, swa_bound, tz, pre, nx < 1024 ? SWA_ITEM(nx) : -1); } }
    if (MIX_MASK & 2) { int z = 0; asm volatile("" : "+v"(z)); const int tz = threadIdx.x + z; for (int it = blockIdx.x; it < 512; it += gridDim.x) mem_item(p, ((((it & 7) * 16 + (it >> 5)) << 2) | ((it >> 3) & 3)), lds, mem_bound, tz); }
    if (MIX_MASK & 4) { int z = 0; asm volatile("" : "+v"(z)); const int tz = threadIdx.x + z; for (int rep = 0; rep < ((MIXDUP & 4) ? 2 : 1); ++rep) for (int it = blockIdx.x; it < 512; it += gridDim.x) conv_item(p, ((it & 7) << 6) | (it >> 3), lds, tz); }
}

__device__ __forceinline__ void phase_h2(const Params& p) {
    const int tid = threadIdx.x, lane = tid & 63, wave = tid >> 6;
    { const int nw = gridDim.x * 8, w0 = blockIdx.x * 8 + wave;
        for (int r = w0; r < S_; r += 4 * nw) {
            if (r + 3 * nw < S_) rms_rows<4>(p.out + (size_t)r * D_, p.g_ffn, (u16*)(p.ws + WS_MERGED) + (size_t)r * D_, (size_t)nw * D_, lane);
            else for (int q = r; q < S_; q += nw) rms_rows<1>(p.out + (size_t)q * D_, p.g_ffn, (u16*)(p.ws + WS_MERGED) + (size_t)q * D_, 0, lane); } }
}

__device__ __forceinline__ void convert_experts(const Params& p, const int part) {
    int zc = 0; asm volatile("" : "+v"(zc)); const int tid = (int)threadIdx.x + zc, lane = tid & 63, wave = tid >> 6;
    for (int rr = part * 8192 + blockIdx.x * 8 + wave; rr < (part + 1) * 8192; rr += gridDim.x * 8) {
        f32x4 v[2][8]; float mx[2] = {0.f, 0.f};
#pragma unroll
        for (int q = 0; q < 2; ++q) { const float* src = (q ? p.ev : p.eu) + (size_t)rr * 2048 + lane * 32;
#pragma unroll
            for (int k = 0; k < 8; ++k) v[q][k] = *(const f32x4*)(src + k * 4); }
#pragma unroll
        for (int q = 0; q < 2; ++q) {
#pragma unroll
            for (int k = 0; k < 8; ++k) mx[q] = fmaxf(mx[q], fmaxf(fmaxf(fabsf(v[q][k][0]), fabsf(v[q][k][1])), fmaxf(fabsf(v[q][k][2]), fabsf(v[q][k][3]))));
            mx[q] = wave_max(mx[q]);
            const u32 mb = __float_as_uint(mx[q]); int eb = (int)((mb >> 23) & 255u); eb = eb < 8 ? 8 : (eb > 250 ? 250 : eb);
            const bool small = (mb & 0x7fffffu) <= 0x700000u;
            const float sc = __uint_as_float((u32)((small ? 256 : 255) - eb) << 23), inv = __uint_as_float((u32)(eb - (small ? 2 : 1)) << 23);
            v16f xa, xb;
#pragma unroll
            for (int i = 0; i < 16; ++i) { xa[i] = v[q][(2 * i) >> 2][(2 * i) & 3] * sc; xb[i] = v[q][(2 * i + 1) >> 2][(2 * i + 1) & 3] * sc; }
            const v6u qq = __builtin_amdgcn_cvt_scalef32_2xpk16_fp6_f32(xa, xb, 1.0f);
            unsigned char* dst = p.ws + WS_EU + (size_t)rr * 3072 + (q ? 1536 : 0);
            *(u32x4*)(dst + lane * 16) = (u32x4){qq[0], qq[1], qq[2], qq[3]};
            *(u32x2*)(dst + 1024 + lane * 8) = (u32x2){qq[4], qq[5]};
            if (lane == 0) ((float*)(p.ws + (q ? WS_SVI : WS_SUI)))[rr] = inv; } }
}

constexpr unsigned char CAND_I[64] = {0,0,0,0,0,0,0,0,0,0,0,0,0,0,0,0,1,1,1,1,1,1,1,1,2,2,2,2,2,3,3,3,3,4,4,4,5,5,6,6,7,7,8,9,10,11,12,13,14,15,255,255,255,255,255,255,255,255,255,255,255,255,255,255};
constexpr unsigned char CAND_J[64] = {0,1,2,3,4,5,6,7,8,9,10,11,12,13,14,15,0,1,2,3,4,5,6,7,0,1,2,3,4,0,1,2,3,0,1,2,0,1,0,1,0,1,0,0,0,0,0,0,0,0,255,255,255,255,255,255,255,255,255,255,255,255,255,255};
__device__ __forceinline__ void sort16_desc(u32 (&a)[16]) {
#pragma unroll
    for (int k = 2; k <= 16; k <<= 1)
#pragma unroll
        for (int j = k >> 1; j > 0; j >>= 1)
#pragma unroll
            for (int i = 0; i < 16; ++i) { const int l = i ^ j;
                if (l > i) { const bool desc = ((i & k) == 0); const u32 hi = max(a[i], a[l]), lo = min(a[i], a[l]); a[i] = desc ? hi : lo; a[l] = desc ? lo : hi; } }
}
__device__ __forceinline__ void merge16_desc(u32 (&R)[16], const u32 (&G)[16]) {
#pragma unroll
    for (int i = 0; i < 16; ++i) R[i] = max(R[i], G[15 - i]);
#pragma unroll
    for (int j = 8; j > 0; j >>= 1)
#pragma unroll
        for (int i = 0; i < 16; ++i) { const int l = i ^ j; if (l > i) { const u32 hi = max(R[i], R[l]), lo = min(R[i], R[l]); R[i] = hi; R[l] = lo; } }
}
__device__ __forceinline__ void topk_rows(const Params& p, unsigned char* lds, const int tok0, const int lgn, const int hbase, const int tid_in) {
    int zi = 0; asm volatile("" : "+v"(zi)); const int tid = tid_in + zi;
    float* sc = (float*)lds;
    float* tv = (float*)lds;
    int* ti = (int*)(lds + 17408);
    const u16* __restrict__ Q = (const u16*)(p.ws + WS_Q); const u16* __restrict__ SK = (const u16*)(p.ws + WS_SK);
    const int nmask = (1 << lgn) - 1;
    const int lane = tid & 63, wave = tid >> 6, fr = lane & 15, fq = lane >> 4;
    {
        const int side = wave & 1, quarter = wave >> 1;
        bf16x8 af[2][4]; int hd[2];
#pragma unroll
        for (int mt = 0; mt < 2; ++mt) { const int rho0 = quarter * 32 + mt * 16; hd[mt] = hbase + (rho0 >> lgn);
#pragma unroll
            for (int ks = 0; ks < 4; ++ks) af[mt][ks] = *(const bf16x8*)(Q + (size_t)(tok0 + ((rho0 + fr) & nmask)) * 2048 + hd[mt] * 256 + side * 128 + ks * 32 + fq * 8); }
        f32x4 acc[2][8];
#pragma unroll
        for (int nt = 0; nt < 8; ++nt) { acc[0][nt] = (f32x4){0.f, 0.f, 0.f, 0.f}; acc[1][nt] = (f32x4){0.f, 0.f, 0.f, 0.f}; }
#pragma unroll
        for (int mt = 0; mt < 2; ++mt)
#pragma unroll
            for (int nt = 0; nt < 8; ++nt)
#pragma unroll
                for (int ks = 0; ks < 4; ++ks) { const bf16x8 b = *(const bf16x8*)(SK + (size_t)((hd[mt] * 2 + side) * 128 + nt * 16 + fr) * 128 + ks * 32 + fq * 8);
                    acc[mt][nt] = mfma16(af[mt][ks], b, acc[mt][nt]); }
#pragma unroll
        for (int mt = 0; mt < 2; ++mt)
#pragma unroll
            for (int nt = 0; nt < 8; ++nt)
#pragma unroll
                for (int j = 0; j < 4; ++j) sc[(side * 128 + quarter * 32 + mt * 16 + fq * 4 + j) * 129 + nt * 16 + fr] = acc[mt][nt][j];
    }
    __syncthreads();
    u32 v[16]; float val[16]; const int tok = tid & 127, sd = (tid >> 7) & 1, half = tid >> 8;
    u32* kbuf = (u32*)(lds + 132096);
    const float* row = sc + (sd * 128 + tok) * 129;
#pragma unroll
    for (int k = 0; k < 16; ++k) { v[k] = 0u; val[k] = 0.f; }
#pragma unroll
    for (int grp = 0; grp < 4; ++grp) { u32 gk[16];
#pragma unroll
        for (int i = 0; i < 16; ++i) { const int n = half * 64 + grp * 16 + i; gk[i] = (mono_key(row[n]) & ~127u) | (u32)(127 - n); }
        sort16_desc(gk);
        if (grp == 0) {
#pragma unroll
            for (int i = 0; i < 16; ++i) v[i] = gk[i]; }
        else merge16_desc(v, gk); }
    if (half) {
#pragma unroll
        for (int k = 0; k < 16; ++k) kbuf[(sd * 128 + tok) * 17 + k] = v[k]; }
    __syncthreads();
    if (!half) { u32 gk[16];
#pragma unroll
        for (int i = 0; i < 16; ++i) gk[i] = kbuf[(sd * 128 + tok) * 17 + i];
        merge16_desc(v, gk);
#pragma unroll
        for (int k = 0; k < 16; ++k) val[k] = row[127 - (int)(v[k] & 127u)]; }
    __syncthreads();
    if (!half) {
#pragma unroll
        for (int k = 0; k < 16; ++k) { tv[(sd * 128 + tok) * 17 + k] = val[k]; ti[(sd * 128 + tok) * 17 + k] = 127 - (int)(v[k] & 127u); } }
    __syncthreads();
    if (tid < 128) { float v1[16], v2[16];
#pragma unroll
        for (int k = 0; k < 16; ++k) { v1[k] = tv[tid * 17 + k]; v2[k] = tv[(128 + tid) * 17 + k]; }
        u32 w[16];
#pragma unroll
        for (int grp = 0; grp < 4; ++grp) { u32 gk[16];
#pragma unroll
            for (int i = 0; i < 16; ++i) { const int c = grp * 16 + i;
                gk[i] = (CAND_I[c] < 16) ? ((mono_key(v1[CAND_I[c] & 15] + v2[CAND_J[c] & 15]) & ~255u) | (u32)(255 - ((CAND_I[c] & 15) * 16 + (CAND_J[c] & 15)))) : 0u; }
            sort16_desc(gk);
            if (grp == 0) {
#pragma unroll
                for (int i = 0; i < 16; ++i) w[i] = gk[i]; }
            else merge16_desc(w, gk); }
        float s[16]; int eid[16]; float m = -3.0e38f;
#pragma unroll
        for (int k = 0; k < 16; ++k) { const int cid = 255 - (int)(w[k] & 255u), i = cid >> 4, j = cid & 15;
            s[k] = tv[tid * 17 + i] + tv[(128 + tid) * 17 + j]; eid[k] = ti[tid * 17 + i] * 128 + ti[(128 + tid) * 17 + j]; m = fmaxf(m, s[k]); }
        float sum = 0.f;
#pragma unroll
        for (int k = 0; k < 16; ++k) { s[k] = __expf(s[k] - m); sum += s[k]; }
        const float inv = 1.f / sum;
        const size_t so = (size_t)(tok0 + (tid & nmask)) * 128 + (hbase + (tid >> lgn)) * 16;
        int* SI = (int*)(p.ws + WS_SI) + so; float* SG = (float*)(p.ws + WS_SG) + so;
        float* SGU = (float*)(p.ws + WS_SGU) + so; const float* SUI = (const float*)(p.ws + WS_SUI); const float* SVI = (const float*)(p.ws + WS_SVI);
        float svi[16], sui[16];
#pragma unroll
        for (int k = 0; k < 16; ++k) { svi[k] = SVI[eid[k]]; sui[k] = SUI[eid[k]]; }
#pragma unroll
        for (int k = 0; k < 16; k += 4) { *(int4*)(SI + k) = make_int4(eid[k], eid[k + 1], eid[k + 2], eid[k + 3]);
            *(f32x4*)(SG + k) = (f32x4){s[k] * inv * svi[k], s[k + 1] * inv * svi[k + 1], s[k + 2] * inv * svi[k + 2], s[k + 3] * inv * svi[k + 3]};
            *(f32x4*)(SGU + k) = (f32x4){sui[k], sui[k + 1], sui[k + 2], sui[k + 3]}; } }
    __syncthreads();
}

__device__ __forceinline__ void peer_token(const Params& p, const int tok, const int lane) {
    const u16* __restrict__ H2 = (const u16*)(p.ws + WS_MERGED);
    const unsigned char* __restrict__ EU = p.ws + WS_EU; const unsigned char* __restrict__ EV = p.ws + WS_EV;
    const int* __restrict__ SI = (const int*)(p.ws + WS_SI); const float* __restrict__ SG = (const float*)(p.ws + WS_SG); const float* __restrict__ SGU = (const float*)(p.ws + WS_SGU);
    {
        f32x2 h[16];
#pragma unroll
        for (int c = 0; c < 4; ++c) { const u32x4 a = *(const u32x4*)(H2 + (size_t)tok * 2048 + lane * 32 + c * 8);
            h[c * 4 + 0] = (f32x2){bf_lo(a.x), bf_hi(a.x)}; h[c * 4 + 1] = (f32x2){bf_lo(a.y), bf_hi(a.y)}; h[c * 4 + 2] = (f32x2){bf_lo(a.z), bf_hi(a.z)}; h[c * 4 + 3] = (f32x2){bf_lo(a.w), bf_hi(a.w)}; }
        const int i0 = SI[(size_t)tok * 128 + lane], i1 = SI[(size_t)tok * 128 + 64 + lane];
        const float g0 = SG[(size_t)tok * 128 + lane], g1 = SG[(size_t)tok * 128 + 64 + lane];
        const float r0 = SGU[(size_t)tok * 128 + lane], r1 = SGU[(size_t)tok * 128 + 64 + lane];
        f32x2 y[16];
#pragma unroll
        for (int k = 0; k < 16; ++k) y[k] = (f32x2){0.f, 0.f};
        u32x4 uA, vA, uB, vB, uC, vC, uD, vD, uE, vE, uF, vF; u32x2 uA2, vA2, uB2, vB2, uC2, vC2, uD2, vD2, uE2, vE2, uF2, vF2;
#define PEER_LOAD(e, U, V) do { const int _e = (e); const int _id = __builtin_amdgcn_readlane(_e < 64 ? i0 : i1, _e & 63); \
            const unsigned char* _pu = EU + (size_t)_id * 3072; const unsigned char* _pv = _pu + 1536; \
            U = *(const u32x4*)(_pu + lane * 16); U##2 = *(const u32x2*)(_pu + 1024 + lane * 8); V = *(const u32x4*)(_pv + lane * 16); V##2 = *(const u32x2*)(_pv + 1024 + lane * 8); } while (0)
#define PEER_COMP(e, U, V) do { const int _e = (e); f32x2 a0 = (f32x2){0.f, 0.f}, a1 = (f32x2){0.f, 0.f}; \
            { const v32f uf = __builtin_amdgcn_cvt_scalef32_pk32_f32_fp6((v6u){U.x, U.y, U.z, U.w, (U##2).x, (U##2).y}, 1.0f); \
            _Pragma("unroll") for (int k = 0; k < 16; k += 2) { a0 = __builtin_elementwise_fma((f32x2){uf[2 * k], uf[2 * k + 1]}, h[k], a0); a1 = __builtin_elementwise_fma((f32x2){uf[2 * k + 2], uf[2 * k + 3]}, h[k + 1], a1); } } \
            const float a = wave_sum((a0.x + a0.y) + (a1.x + a1.y)) * rdlane(_e < 64 ? r0 : r1, _e & 63); const float gt_ = rdlane(_e < 64 ? g0 : g1, _e & 63); \
            const float act = 0.5f * a * (1.f + erff(a * 0.70710678118654752f)) * gt_; const f32x2 act2 = (f32x2){act, act}; \
            { const v32f vf = __builtin_amdgcn_cvt_scalef32_pk32_f32_fp6((v6u){V.x, V.y, V.z, V.w, (V##2).x, (V##2).y}, 1.0f); \
            _Pragma("unroll") for (int k = 0; k < 16; ++k) y[k] = __builtin_elementwise_fma((f32x2){vf[2 * k], vf[2 * k + 1]}, act2, y[k]); } } while (0)
        PEER_LOAD(0, uA, vA); PEER_LOAD(1, uB, vB); PEER_LOAD(2, uC, vC); PEER_LOAD(3, uD, vD); PEER_LOAD(4, uE, vE);
        for (int e = 0; e < 126; e += 6) {
            PEER_LOAD(e + 5, uF, vF);
            PEER_COMP(e, uA, vA);
            PEER_LOAD(e + 6, uA, vA);
            PEER_COMP(e + 1, uB, vB);
            PEER_LOAD(e + 7, uB, vB);
            PEER_COMP(e + 2, uC, vC);
            if (e + 8 < 128) PEER_LOAD(e + 8, uC, vC);
            PEER_COMP(e + 3, uD, vD);
            if (e + 8 < 128) PEER_LOAD(e + 9, uD, vD);
            PEER_COMP(e + 4, uE, vE);
            if (e + 8 < 128) PEER_LOAD(e + 10, uE, vE);
            PEER_COMP(e + 5, uF, vF);
        }
        PEER_COMP(126, uA, vA); PEER_COMP(127, uB, vB);
#undef PEER_LOAD
#undef PEER_COMP
        float* op = p.out + (size_t)tok * 2048 + lane * 32; f32x4 xo[8];
#pragma unroll
        for (int k = 0; k < 8; ++k) xo[k] = *(const f32x4*)(op + k * 4);
#pragma unroll
        for (int k = 0; k < 8; ++k) { f32x4 a = xo[k];
            a[0] += y[2 * k].x; a[1] += y[2 * k].y; a[2] += y[2 * k + 1].x; a[3] += y[2 * k + 1].y;
            *(f32x4*)(op + k * 4) = a; }
    }
}


__device__ __forceinline__ void phase_topk_peer(const Params& p, unsigned char* lds) {
    for (int tb = blockIdx.x; tb < S_ / 64; tb += gridDim.x) {
        const int pat = ((blockIdx.x >> 3) & 1) ? 1 : 2;
        const int code = pat == 1 ? 0x4310 : 0x420, nb = (pat & 1) ? 3 : 2;
#pragma unroll 1
        for (int bi = 0; bi < nb; ++bi) {
            const int u0 = (code >> (4 * bi)) & 15, u1 = (code >> (4 * bi + 4)) & 15, t0 = tb * 64 + u0 * 16, ntok = (u1 - u0) * 16;
#pragma unroll 1
            for (int u = u0; u < u1; ++u) topk_rows(p, lds, tb * 64 + u * 16, 4, 0, (int)threadIdx.x);
            __syncthreads();
            { int z = 0; asm volatile("" : "+v"(z)); const int tz = (int)threadIdx.x + z; const int lane = tz & 63, wave = __builtin_amdgcn_readfirstlane(tz >> 6), per = ntok >> 3;
#pragma unroll 1
                for (int i = 0; i < per; ++i) peer_token(p, t0 + wave * per + i, lane); }
        }
    }
}

constexpr int N_PHASES = 8;
#ifndef DUPMASK
#define DUPMASK 0
#endif
#ifndef PH_MASK
#define PH_MASK 0x1ff
#endif

__device__ __forceinline__ void late_transposes(const Params& p, unsigned char* lds) {
    float* T = (float*)lds; unsigned char* ws = p.ws;
    for (int j = blockIdx.x * 4; j < 3072; j += gridDim.x * 4) {
        if (j < 512) cvt_tr_tile4(p.w_attn_o, (u16*)(ws + WS_WA_T), 1024, 2048, j, T, 2048);
        else if (j < 768) cvt_tr_tile4(p.w_conv_o, (u16*)(ws + WS_WA_T) + 1024, 512, 2048, j - 512, T, 2048);
        else if (j < 1024) cvt_tr_tile4(p.w_mem_o, (u16*)(ws + WS_WA_T) + 1536, 512, 2048, j - 768, T, 2048);
        else if (j < 2048) cvt_tr_tile4(p.w_out, (u16*)(ws + WS_WOUT_T), 2048, 2048, j - 1024, T, 2048);
        else cvt_tr_tile4(p.w_query, (u16*)(ws + WS_WQ_T), 2048, 2048, j - 2048, T, 2048);
    }
    const int tid = threadIdx.x;
    const int gt = blockIdx.x * NTHR + tid, gn = gridDim.x * NTHR;
    for (int i = gt; i < S_ * 32; i += gn) { const int t = i >> 5, j = i & 31;
        const double invf = exp2(-(double)j * (13.287712379549449 / 32.0));
        const double ang = (double)p.pos[t] * invf;
        const double n = rint(ang * 0.15915494309189535);
        double r = fma(-n, 6.283185307179586, ang); r = fma(-n, 2.4492935982947064e-16, r);
        double s, c; sincos_d(r, s, c);
        ((float*)(ws + WS_COS))[i] = (float)c; ((float*)(ws + WS_SIN))[i] = (float)s; }
    for (int i = gt; i < 16 * 128 * 128 / 4; i += gn) { const f32x4 v = ((const f32x4*)p.sub_keys)[i]; u32x2 w; w.x = pk_bf16(v[0], v[1]); w.y = pk_bf16(v[2], v[3]); ((u32x2*)(ws + WS_SK))[i] = w; }
}

__device__ __forceinline__ void memkv_direct(const Params& p, unsigned char* lds) {
    const u16* __restrict__ A = (const u16*)(p.ws + WS_MEMN); const u16* __restrict__ B = (const u16*)(p.ws + WS_WKV_T);
    u16* O = (u16*)(p.ws + WS_MEMKV);
    float* red = (float*)lds;
    int z = 0; asm volatile("" : "+v"(z));
    const int tid = threadIdx.x + z, lane = tid & 63, wave = tid >> 6, fr = lane & 15, fq = lane >> 4, tw = wave & 3, kh = wave >> 2;
    for (int base = blockIdx.x * 4; base < 1024; base += gridDim.x * 4) {
        const int tile = base + tw, mt = tile & 15, nt = tile >> 4;
        const u16* ap = A + (size_t)(mt * 16 + fr) * 2048 + kh * 1024 + fq * 8; const u16* bp = B + (size_t)(nt * 16 + fr) * 2048 + kh * 1024 + fq * 8;
        f32x4 acc = (f32x4){0.f, 0.f, 0.f, 0.f};
#pragma unroll 8
        for (int ks = 0; ks < 32; ++ks) acc = mfma16(*(const bf16x8*)(ap + ks * 32), *(const bf16x8*)(bp + ks * 32), acc);
        if (kh) *(f32x4*)(red + (tw * 64 + lane) * 4) = acc;
        __syncthreads();
        if (!kh) { const f32x4 o = acc + *(const f32x4*)(red + (tw * 64 + lane) * 4);
#pragma unroll
            for (int j = 0; j < 4; ++j) O[(size_t)(mt * 16 + fq * 4 + j) * 1024 + nt * 16 + fr] = (u16)pk_bf16(o[j], 0.f); }
        __syncthreads();
    }
}
template <bool HOOKED> __device__ __forceinline__ void run_gemms(const Params& p, unsigned char* lds, const int j0, const int j1) {
    unsigned char* ws = p.ws;
    for (int j = j0; j < j1; ++j) {
        pg8::Gemm g; EpiU<HOOKED> E; E.mode = 0; E.O = nullptr; E.Of = nullptr; E.X = nullptr; E.G = nullptr; E.ldc = 0; E.ldg = INW; E.sig_from = 1 << 30;
        u16* proj = (u16*)(ws + WS_PROJ); u16* merged = (u16*)(ws + WS_MERGED);
        const u16* BO = (const u16*)((unsigned char*)p.out + 67108864);
        if (j == 0) { g = pg8::Gemm{(const u16*)p.out, (const u16*)(ws + WS_WIN_T), S_, INW, D_}; E.O = proj; E.ldc = INW; E.sig_from = C_GA; }
        else if (j == 1) { g = pg8::Gemm{(const u16*)(ws + WS_MEMN), (const u16*)(ws + WS_WKV_T), 256, 1024, D_}; E.O = (u16*)(ws + WS_MEMKV); E.ldc = 1024; }
        else if (j == 2) { g = pg8::Gemm{BO, (const u16*)(ws + WS_WA_T), S_, D_, D_}; E.mode = 1; E.O = merged; E.ldc = D_; E.G = proj + C_GA; }
        else if (j == 5) { g = pg8::Gemm{merged, (const u16*)(ws + WS_WOUT_T), S_, D_, D_}; E.mode = 2; E.Of = p.out; E.X = p.x; E.ldc = D_; }
        else { g = pg8::Gemm{merged, (const u16*)(ws + WS_WQ_T), S_, D_, D_}; E.O = (u16*)(ws + WS_Q); E.ldc = D_; }
        pg8::StaticOrder So; So.init(g.M, g.N, (int)gridDim.x, (int)blockIdx.x);
        pg8::gemm_phase<EpiU<HOOKED>, pg8::StaticOrder>((PG8_LAS unsigned char*)lds, g, So, E, nullptr);
        __syncthreads();
    }
}
__global__ void __launch_bounds__(NTHR, 2) hybrid_fwd(Params p) {
    extern __shared__ __attribute__((aligned(16))) unsigned char lds[];
    cg::grid_group grid = cg::this_grid();
    if (p.ph_lo < 0) grid.sync();
    volatile LAS unsigned* bst = (volatile LAS unsigned*)((LAS unsigned char*)lds + (LDS_BYTES - 16));
    if (threadIdx.x < 4) bst[threadIdx.x] = 0u;
    __syncthreads();
    XcdBarrier xbar = xcd_barrier_post((unsigned*)(p.ws + WS_BAR), bst);
#define IN(k) (p.ph_lo <= (k) && (k) < p.ph_hi)
#define SEAM(k) do { if (IN(k) && IN((k) + 1)) xcd_barrier(xbar); } while (0)
#define RUNPH(k, ...) __VA_ARGS__ SEAM(k); if (DUPMASK & (1 << (k))) { __VA_ARGS__ SEAM(k); }
    RUNPH(0, if ((PH_MASK & 1) && IN(0)) phase_prep(p, lds);)
    RUNPH(1, if ((PH_MASK & 2) && IN(1)) { const bool first = ((blockIdx.x >> 3) & 1) != 0; if (first) late_transposes(p, lds); run_gemms<false>(p, lds, 0, 1); memkv_direct(p, lds); if (!first) late_transposes(p, lds); })
    RUNPH(2, if ((PH_MASK & 4) && IN(2)) phase_mix(p, lds);)
    RUNPH(3, if ((PH_MASK & 8) && IN(3)) { const bool first = ((blockIdx.x >> 3) & 1) != 0; if (first) convert_experts(p, 0); run_gemms<true>(p, lds, 2, 3); if (!first) convert_experts(p, 0); })
    RUNPH(4, if ((PH_MASK & 16) && IN(4)) { const bool first = ((blockIdx.x >> 3) & 1) != 0; if (first) convert_experts(p, 1); run_gemms<false>(p, lds, 5, 6); if (!first) convert_experts(p, 1); })
    RUNPH(5, if ((PH_MASK & 32) && IN(5)) phase_h2(p);)
    RUNPH(6, if ((PH_MASK & 64) && IN(6)) run_gemms<false>(p, lds, 6, 7);)
    RUNPH(7, if ((PH_MASK & 128) && IN(7)) phase_topk_peer(p, lds);)
#ifdef EXTRA_SYNCS
    for (int i = 0; i < EXTRA_SYNCS; ++i) xcd_barrier(xbar);
#endif
    (void)0;
#undef IN
#undef SEAM
}

#ifndef MK_LAUNCHES
#define MK_LAUNCHES 1
#endif
extern "C" void kernel_launch(void* const* d_in, const int* in_sizes, int n_in, void* d_out, int out_size, void* d_ws, size_t ws_size, hipStream_t stream) {
    static int grid = 0;
    if (grid == 0) {
        if (n_in != 25 || out_size != S_ * D_ || ws_size < WS_TOTAL) { fprintf(stderr, "kernel_launch: unexpected shapes (n_in %d out %d ws %zu need %zu)\n", n_in, out_size, ws_size, (size_t)WS_TOTAL); grid = -1; return; }
        int dev = 0, cus = 0, per_cu = 0;
        hipGetDevice(&dev); hipDeviceGetAttribute(&cus, hipDeviceAttributeMultiprocessorCount, dev);
        if (hipFuncSetAttribute((const void*)hybrid_fwd, hipFuncAttributeMaxDynamicSharedMemorySize, LDS_BYTES) != hipSuccess) { fprintf(stderr, "kernel_launch: hipFuncSetAttribute failed\n"); grid = -1; return; }
        if (hipOccupancyMaxActiveBlocksPerMultiprocessor(&per_cu, (const void*)hybrid_fwd, NTHR, LDS_BYTES) != hipSuccess || per_cu < 1) { fprintf(stderr, "kernel_launch: occupancy query gave %d\n", per_cu); per_cu = 1; }
        (void)hipGetLastError();
        grid = cus * per_cu;
    }
    if (grid < 0) return;
    Params p{};
    p.x = (const float*)d_in[0]; p.mem = (const float*)d_in[1]; p.pos = (const int*)d_in[2]; p.g_mix = (const float*)d_in[3]; p.w_in = (const float*)d_in[4];
    p.qg = (const float*)d_in[5]; p.kg = (const float*)d_in[6]; p.sinks = (const float*)d_in[7]; p.w_attn_o = (const float*)d_in[8]; p.dw_w = (const float*)d_in[9];
    p.dw_b = (const float*)d_in[10]; p.ln_g = (const float*)d_in[11]; p.ln_b = (const float*)d_in[12]; p.w_conv_o = (const float*)d_in[13]; p.g_mem = (const float*)d_in[14];
    p.w_mem_kv = (const float*)d_in[15]; p.mqg = (const float*)d_in[16]; p.mkg = (const float*)d_in[17]; p.w_mem_o = (const float*)d_in[18]; p.w_out = (const float*)d_in[19];
    p.g_ffn = (const float*)d_in[20]; p.w_query = (const float*)d_in[21]; p.sub_keys = (const float*)d_in[22]; p.eu = (const float*)d_in[23]; p.ev = (const float*)d_in[24];
    p.out = (float*)d_out; p.ws = (unsigned char*)d_ws;
#if MK_LAUNCHES == 1
    if (hipMemsetAsync((unsigned char*)d_ws + WS_BAR, 0, 16384, stream) != hipSuccess) { fprintf(stderr, "kernel_launch: memset of the barrier words failed\n"); return; }
    p.ph_lo = 0; p.ph_hi = N_PHASES;
    void* args[] = {&p};
    hipError_t e = hipLaunchCooperativeKernel((const void*)hybrid_fwd, dim3(grid), dim3(NTHR), args, LDS_BYTES, stream);
    if (e != hipSuccess) fprintf(stderr, "kernel_launch: cooperative launch failed: %s (grid %d)\n", hipGetErrorString(e), grid);
#else
    for (int ph = 0; ph < N_PHASES; ++ph) { p.ph_lo = ph; p.ph_hi = ph + 1; hipLaunchKernelGGL(hybrid_fwd, dim3(grid), dim3(NTHR), LDS_BYTES, stream, p); }
#endif
}
```
